# Optimizing an MI355X kernel written in HIP

```python
import functools
import jax
import jax.numpy as jnp
from jax import lax
import numpy as np

D_MODEL = 1024
BATCH = 4
SEQ = 8192
DEPTH = 4

GRID_W = 64
CTX_LEN = 256
N_MIXERS = 3
EPS = 1e-6
NEG_INF = -1e30
ROPE_BASE = 10000.0
ADA_STD = 0.02

A_HEADS = 16
A_KV_HEADS = 4
A_HEAD_DIM = 64
A_WINDOW = 128
A_BLOCK = 128
A_WIDTH = A_HEADS * A_HEAD_DIM
A_KV_WIDTH = A_KV_HEADS * A_HEAD_DIM
A_IN = 2 * A_WIDTH + 2 * A_KV_WIDTH

B_HEADS = 8
B_NOPE = 128
B_ROPE = 64
B_VDIM = 128
B_Q_RANK = 256
B_KV_RANK = 128
B_BLOCK = 128
B_WIDTH = B_HEADS * B_VDIM
B_IN = B_Q_RANK + B_KV_RANK + B_ROPE + B_WIDTH

C_HEADS = 4
C_QK_DIM = 128
C_V_DIM = 256
C_QK_WIDTH = C_HEADS * C_QK_DIM
C_WIDTH = C_HEADS * C_V_DIM
C_CONV = 5
C_CHUNK = 128
C_IN = 2 * C_QK_WIDTH + 3 * C_WIDTH + 4 * C_HEADS
F_BIAS = 3.0

kernel_name = 'hybrid_dit_gqa_mla_mlstm'


def rmsnorm(x, g):
    xf = x.astype(jnp.float32)
    y = xf * lax.rsqrt(jnp.mean(xf * xf, axis=-1, keepdims=True) + EPS)
    return (y * g.astype(jnp.float32)).astype(x.dtype)


def axial_rope(n_tok, rot_dim, dtype):
    rows = n_tok // GRID_W
    r, cidx = jnp.meshgrid(jnp.arange(rows), jnp.arange(GRID_W), indexing='ij')
    r = r.reshape(-1).astype(jnp.float32)
    cc = cidx.reshape(-1).astype(jnp.float32)
    n_freq = rot_dim // 4
    inv = ROPE_BASE ** (-jnp.arange(n_freq, dtype=jnp.float32) / n_freq)
    ang = jnp.concatenate([r[:, None] * inv, cc[:, None] * inv], axis=-1)
    return jnp.cos(ang).astype(dtype), jnp.sin(ang).astype(dtype)


def apply_rope(x, cos, sin):
    x1, x2 = x[..., 0::2], x[..., 1::2]
    cos, sin = cos[:, None, :], sin[:, None, :]
    return jnp.stack([x1 * cos - x2 * sin, x1 * sin + x2 * cos], axis=-1).reshape(x.shape)


def sink_softmax(logits, sink):
    m = jnp.maximum(jnp.max(logits, axis=-1, keepdims=True), sink)
    e = jnp.exp(logits - m)
    return e / (jnp.sum(e, axis=-1, keepdims=True) + jnp.exp(sink - m))


def centred_dwconv(x, w):
    k = w.shape[0]
    return lax.conv_general_dilated(x, w[:, None, :].astype(x.dtype), window_strides=(1,),
                                    padding=[(k // 2, k // 2)],
                                    dimension_numbers=('NWC', 'WIO', 'NWC'),
                                    feature_group_count=x.shape[-1])


def window_gqa_mixer(h_lat, h_ctx, need_ctx, w_in, sink, w_out):
    bsz, n_lat, _ = h_lat.shape
    n_ctx = h_ctx.shape[1]
    grp = A_HEADS // A_KV_HEADS
    scale = A_HEAD_DIM ** -0.5
    cuts = [A_WIDTH, A_WIDTH + A_KV_WIDTH, A_WIDTH + 2 * A_KV_WIDTH]
    sink_l = sink.astype(jnp.float32).reshape(A_KV_HEADS, grp, 1, 1)

    q_l, k_l, v_l, z_l = jnp.split(h_lat @ w_in, cuts, axis=-1)
    if need_ctx:
        q_c, k_c, v_c, z_c = jnp.split(h_ctx @ w_in, cuts, axis=-1)
    else:
        k_c, v_c = jnp.split(h_ctx @ w_in[:, A_WIDTH:A_WIDTH + 2 * A_KV_WIDTH], 2, axis=-1)
    k_c = k_c.reshape(bsz, n_ctx, A_KV_HEADS, A_HEAD_DIM)
    v_c = v_c.reshape(bsz, n_ctx, A_KV_HEADS, A_HEAD_DIM)

    cos, sin = axial_rope(n_lat, A_HEAD_DIM, h_lat.dtype)
    q_l = apply_rope(q_l.reshape(bsz, n_lat, A_HEADS, A_HEAD_DIM), cos, sin)
    q_l = q_l.reshape(bsz, n_lat, A_KV_HEADS, grp, A_HEAD_DIM)
    k_l = apply_rope(k_l.reshape(bsz, n_lat, A_KV_HEADS, A_HEAD_DIM), cos, sin)
    v_l = v_l.reshape(bsz, n_lat, A_KV_HEADS, A_HEAD_DIM)

    pad = ((0, 0), (A_BLOCK, A_BLOCK), (0, 0), (0, 0))
    k_pad, v_pad = jnp.pad(k_l, pad), jnp.pad(v_l, pad)
    band = 3 * A_BLOCK
    k_off = jnp.arange(band) - A_BLOCK
    in_window = jnp.abs(k_off[None, :] - jnp.arange(A_BLOCK)[:, None]) <= A_WINDOW
    ctx_ok = jnp.ones((A_BLOCK, n_ctx), dtype=bool)

    def block(n):
        start = n * A_BLOCK
        q_b = lax.dynamic_slice_in_dim(q_l, start, A_BLOCK, axis=1)
        k_b = jnp.concatenate([lax.dynamic_slice_in_dim(k_pad, start, band, axis=1), k_c], axis=1)
        v_b = jnp.concatenate([lax.dynamic_slice_in_dim(v_pad, start, band, axis=1), v_c], axis=1)
        kpos = start + k_off
        valid = in_window & ((kpos >= 0) & (kpos < n_lat))[None, :]
        mask = jnp.concatenate([valid, ctx_ok], axis=1)
        logits = jnp.einsum('bqkgd,bjkd->bkgqj', q_b, k_b).astype(jnp.float32) * scale
        p = sink_softmax(jnp.where(mask, logits, NEG_INF), sink_l)
        return jnp.einsum('bkgqj,bjkd->bqkgd', p.astype(v_b.dtype), v_b)

    o = lax.map(block, jnp.arange(n_lat // A_BLOCK))
    o_l = jnp.moveaxis(o, 0, 1).reshape(bsz, n_lat, A_WIDTH)
    y_l = (o_l * jax.nn.silu(z_l)) @ w_out

    y_c = None
    if need_ctx:
        q_c = q_c.reshape(bsz, n_ctx, A_KV_HEADS, grp, A_HEAD_DIM)
        logits = jnp.einsum('bqkgd,bjkd->bkgqj', q_c, k_c).astype(jnp.float32) * scale
        p = sink_softmax(logits, sink_l)
        o_c = jnp.einsum('bkgqj,bjkd->bqkgd', p.astype(v_c.dtype), v_c).reshape(bsz, n_ctx, A_WIDTH)
        y_c = (o_c * jax.nn.silu(z_c)) @ w_out
    return y_l, y_c


def mla_mixer(h_lat, h_ctx, need_ctx, w_in, g_qa, g_kva, w_uq, w_ukv, w_out):
    bsz, n_lat, _ = h_lat.shape
    n_ctx = h_ctx.shape[1]
    dqk = B_NOPE + B_ROPE
    scale = dqk ** -0.5
    cuts = [B_Q_RANK, B_Q_RANK + B_KV_RANK, B_Q_RANK + B_KV_RANK + B_ROPE]

    def queries(q_a):
        b, n, _ = q_a.shape
        return (rmsnorm(q_a, g_qa) @ w_uq).reshape(b, n, B_HEADS, dqk)

    def keys_values(kv_a, k_pe):
        b, n, _ = kv_a.shape
        kv = (rmsnorm(kv_a, g_kva) @ w_ukv).reshape(b, n, B_HEADS, B_NOPE + B_VDIM)
        k_nope, v = jnp.split(kv, [B_NOPE], axis=-1)
        k_pe = jnp.broadcast_to(k_pe[:, :, None, :], (b, n, B_HEADS, B_ROPE))
        return jnp.concatenate([k_nope, k_pe], axis=-1), v

    q_a_l, kv_a_l, kpe_l, z_l = jnp.split(h_lat @ w_in, cuts, axis=-1)
    if need_ctx:
        q_a_c, kv_a_c, kpe_c, z_c = jnp.split(h_ctx @ w_in, cuts, axis=-1)
    else:
        kv_a_c, kpe_c = jnp.split(h_ctx @ w_in[:, B_Q_RANK:cuts[2]], [B_KV_RANK], axis=-1)

    cos, sin = axial_rope(n_lat, B_ROPE, h_lat.dtype)
    q_l = queries(q_a_l)
    q_l = jnp.concatenate([q_l[..., :B_NOPE], apply_rope(q_l[..., B_NOPE:], cos, sin)], axis=-1)
    kpe_l = apply_rope(kpe_l[:, :, None, :], cos, sin)[:, :, 0]
    k_l, v_l = keys_values(kv_a_l, kpe_l)
    k_c, v_c = keys_values(kv_a_c, kpe_c)

    k_all = jnp.concatenate([k_c, k_l], axis=1)
    v_all = jnp.concatenate([v_c, v_l], axis=1)

    def block(q_b):
        logits = jnp.einsum('bqhd,bkhd->bhqk', q_b, k_all).astype(jnp.float32) * scale
        p = jax.nn.softmax(logits, axis=-1)
        return jnp.einsum('bhqk,bkhd->bqhd', p.astype(v_all.dtype), v_all)

    nb = n_lat // B_BLOCK
    q_blocks = jnp.moveaxis(q_l.reshape(bsz, nb, B_BLOCK, B_HEADS, dqk), 1, 0)
    o = lax.map(block, q_blocks)
    o_l = jnp.moveaxis(o, 0, 1).reshape(bsz, n_lat, B_WIDTH)
    y_l = (o_l * jax.nn.silu(z_l)) @ w_out

    y_c = None
    if need_ctx:
        q_c = queries(q_a_c)
        logits = jnp.einsum('bqhd,bkhd->bhqk', q_c, k_c).astype(jnp.float32) * scale
        p = jax.nn.softmax(logits, axis=-1)
        o_c = jnp.einsum('bhqk,bkhd->bqhd', p.astype(v_c.dtype), v_c).reshape(bsz, n_ctx, B_WIDTH)
        y_c = (o_c * jax.nn.silu(z_c)) @ w_out
    return y_l, y_c


def mlstm_chunkwise(q, k, v, i_pre, f_pre, state, need_out):
    b, h, t, dk = q.shape
    dv = v.shape[-1]
    nc = t // C_CHUNK
    q = q.reshape(b, h, nc, C_CHUNK, dk)
    k = k.reshape(b, h, nc, C_CHUNK, dk)
    v = v.reshape(b, h, nc, C_CHUNK, dv)
    ig = i_pre.reshape(b, h, nc, C_CHUNK)
    cum = jnp.cumsum(jax.nn.log_sigmoid(f_pre).reshape(b, h, nc, C_CHUNK), axis=-1)
    tot = cum[..., -1]

    w_end = tot[..., None] - cum + ig
    m_loc = jnp.max(w_end, axis=-1)
    e_end = jnp.exp(w_end - m_loc[..., None])
    c_loc = jnp.einsum('bhcs,bhcsv,bhcsk->bhcvk', e_end, v, k)
    n_loc = jnp.einsum('bhcs,bhcsk->bhck', e_end, k)

    def step(carry, inp):
        c_prev, n_prev, m_prev = carry
        tot_c, m_l, c_l, n_l = inp
        m_new = jnp.maximum(tot_c + m_prev, m_l)
        a = jnp.exp(tot_c + m_prev - m_new)
        bb = jnp.exp(m_l - m_new)
        new = (a[..., None, None] * c_prev + bb[..., None, None] * c_l,
               a[..., None] * n_prev + bb[..., None] * n_l, m_new)
        return new, carry

    to_front = lambda a: jnp.moveaxis(a, 2, 0)
    final, starts = lax.scan(step, state, (to_front(tot), to_front(m_loc), to_front(c_loc), to_front(n_loc)))
    if not need_out:
        return None, final
    c_st, n_st, m_st = (jnp.moveaxis(s, 0, 2) for s in starts)

    tri = jnp.tril(jnp.ones((C_CHUNK, C_CHUNK), dtype=bool))
    log_d = jnp.where(tri, cum[..., :, None] - cum[..., None, :] + ig[..., None, :], NEG_INF)
    inter = cum + m_st[..., None]
    m_t = jnp.maximum(inter, jnp.max(log_d, axis=-1))
    s_qk = jnp.einsum('bhctd,bhcsd->bhcts', q, k) * jnp.exp(log_d - m_t[..., None])
    a_t = jnp.exp(inter - m_t)
    num = (jnp.einsum('bhcts,bhcsv->bhctv', s_qk, v)
           + a_t[..., None] * jnp.einsum('bhcvk,bhctk->bhctv', c_st, q))
    den = jnp.sum(s_qk, axis=-1) + a_t * jnp.einsum('bhck,bhctk->bhct', n_st, q)
    out = num / jnp.maximum(jnp.abs(den), jnp.exp(-m_t))[..., None]
    return out.reshape(b, h, t, dv), final


def mlstm_mixer(h_lat, h_ctx, need_ctx, w_in, conv, b_gate, g_head, w_out):
    bsz = h_lat.shape[0]
    cuts = [2 * C_QK_WIDTH, 2 * C_QK_WIDTH + C_WIDTH, 2 * C_QK_WIDTH + 2 * C_WIDTH, 2 * C_QK_WIDTH + 3 * C_WIDTH]

    def prepare(h):
        b, n, _ = h.shape
        qk, v, o, z, gates = jnp.split(h @ w_in, cuts, axis=-1)
        qk = jax.nn.silu(centred_dwconv(qk, conv))
        q, k = jnp.split(qk, 2, axis=-1)
        heads = lambda a, d: jnp.moveaxis(a.reshape(b, n, C_HEADS, d), 2, 1).astype(jnp.float32)
        q = heads(q, C_QK_DIM)
        k = heads(k, C_QK_DIM) * (C_QK_DIM ** -0.5)
        v = heads(v, C_V_DIM)
        gates = jnp.moveaxis((gates + b_gate).astype(jnp.float32).reshape(b, n, 4, C_HEADS), 1, -1)
        return q, k, v, o, z, gates

    def finish(hsum, o, z):
        b, n, _ = o.shape
        hh = jnp.moveaxis(hsum, 1, 2).astype(o.dtype)
        hh = hh * jax.nn.sigmoid(o).reshape(b, n, C_HEADS, C_V_DIM)
        hh = rmsnorm(hh, g_head.reshape(C_HEADS, C_V_DIM)).reshape(b, n, C_WIDTH)
        return (hh * jax.nn.silu(z)) @ w_out

    q_c, k_c, v_c, o_c, z_c, g_c = prepare(h_ctx)
    q_l, k_l, v_l, o_l, z_l, g_l = prepare(h_lat)
    zero_state = (jnp.zeros((bsz, C_HEADS, C_V_DIM, C_QK_DIM), jnp.float32),
                  jnp.zeros((bsz, C_HEADS, C_QK_DIM), jnp.float32),
                  jnp.full((bsz, C_HEADS), NEG_INF, jnp.float32))
    flip = lambda a: jnp.flip(a, axis=2)

    hc_f, st_f = mlstm_chunkwise(q_c, k_c, v_c, g_c[:, 0], g_c[:, 1], zero_state, need_ctx)
    hl_f, _ = mlstm_chunkwise(q_l, k_l, v_l, g_l[:, 0], g_l[:, 1], st_f, True)
    hc_b, st_b = mlstm_chunkwise(flip(q_c), flip(k_c), flip(v_c), flip(g_c[:, 2]), flip(g_c[:, 3]), zero_state, need_ctx)
    hl_b, _ = mlstm_chunkwise(flip(q_l), flip(k_l), flip(v_l), flip(g_l[:, 2]), flip(g_l[:, 3]), st_b, True)

    y_l = finish(hl_f + flip(hl_b), o_l, z_l)
    y_c = finish(hc_f + flip(hc_b), o_c, z_c) if need_ctx else None
    return y_l, y_c


def _normal(key, shape, std):
    return std * jax.random.normal(key, shape, jnp.float32)


def _gain(key, n):
    return 1.0 + 0.1 * jax.random.normal(key, (n,), jnp.float32)


def _layer_params(key, kind):
    ks = jax.random.split(key, 10)
    p = {
        'w_ada': _normal(ks[0], (D_MODEL, 3 * D_MODEL), ADA_STD),
        'b_ada': _normal(ks[1], (3 * D_MODEL,), 0.02),
        'g_pre': _gain(ks[2], D_MODEL),
        'g_post': _gain(ks[3], D_MODEL),
    }
    if kind == 0:
        p['w_in'] = _normal(ks[4], (D_MODEL, A_IN), D_MODEL ** -0.5)
        p['sink'] = _normal(ks[5], (A_HEADS,), 0.5)
        p['w_out'] = _normal(ks[6], (A_WIDTH, D_MODEL), A_WIDTH ** -0.5)
    elif kind == 1:
        p['w_in'] = _normal(ks[4], (D_MODEL, B_IN), D_MODEL ** -0.5)
        p['g_qa'] = _gain(ks[5], B_Q_RANK)
        p['g_kva'] = _gain(ks[6], B_KV_RANK)
        p['w_uq'] = _normal(ks[7], (B_Q_RANK, B_HEADS * (B_NOPE + B_ROPE)), B_Q_RANK ** -0.5)
        p['w_ukv'] = _normal(ks[8], (B_KV_RANK, B_HEADS * (B_NOPE + B_VDIM)), B_KV_RANK ** -0.5)
        p['w_out'] = _normal(ks[9], (B_WIDTH, D_MODEL), B_WIDTH ** -0.5)
    else:
        offset = jnp.repeat(jnp.array([0.0, F_BIAS, 0.0, F_BIAS], jnp.float32), C_HEADS)
        p['w_in'] = _normal(ks[4], (D_MODEL, C_IN), D_MODEL ** -0.5)
        p['conv'] = _normal(ks[5], (C_CONV, 2 * C_QK_WIDTH), C_CONV ** -0.5)
        p['b_gate'] = offset + _normal(ks[6], (4 * C_HEADS,), 0.3)
        p['g_head'] = _gain(ks[7], C_WIDTH)
        p['w_out'] = _normal(ks[8], (C_WIDTH, D_MODEL), C_WIDTH ** -0.5)
    return p


def setup_inputs(seed: int = 0) -> dict:
    key = jax.random.key(seed)
    k_x, k_c, k_ctx, k_cc, k_layers = jax.random.split(key, 5)
    inputs = {
        'x': jax.random.normal(k_x, (BATCH, SEQ, D_MODEL), jnp.float32),
        'c': jax.random.normal(k_c, (BATCH, D_MODEL), jnp.float32),
        'ctx': jax.random.normal(k_ctx, (BATCH, CTX_LEN, D_MODEL), jnp.float32),
        'c_ctx': jax.random.normal(k_cc, (D_MODEL,), jnp.float32),
    }
    for i, lk in enumerate(jax.random.split(k_layers, DEPTH)):
        for name, val in _layer_params(lk, i % N_MIXERS).items():
            inputs[f'l{i}_{name}'] = val
    return inputs


def modulation(cvec, w_ada, b_ada):
    return jnp.split(jax.nn.silu(cvec) @ w_ada + b_ada, 3, axis=-1)


def reference(x, c, ctx, c_ctx,
              l0_w_ada, l0_b_ada, l0_g_pre, l0_g_post, l0_w_in, l0_sink, l0_w_out,
              l1_w_ada, l1_b_ada, l1_g_pre, l1_g_post, l1_w_in, l1_g_qa, l1_g_kva, l1_w_uq, l1_w_ukv, l1_w_out,
              l2_w_ada, l2_b_ada, l2_g_pre, l2_g_post, l2_w_in, l2_conv, l2_b_gate, l2_g_head, l2_w_out,
              l3_w_ada, l3_b_ada, l3_g_pre, l3_g_post, l3_w_in, l3_sink, l3_w_out):
    layers = [
        (l0_w_ada, l0_b_ada, l0_g_pre, l0_g_post,
         functools.partial(window_gqa_mixer, w_in=l0_w_in, sink=l0_sink, w_out=l0_w_out)),
        (l1_w_ada, l1_b_ada, l1_g_pre, l1_g_post,
         functools.partial(mla_mixer, w_in=l1_w_in, g_qa=l1_g_qa, g_kva=l1_g_kva,
                           w_uq=l1_w_uq, w_ukv=l1_w_ukv, w_out=l1_w_out)),
        (l2_w_ada, l2_b_ada, l2_g_pre, l2_g_post,
         functools.partial(mlstm_mixer, w_in=l2_w_in, conv=l2_conv, b_gate=l2_b_gate,
                           g_head=l2_g_head, w_out=l2_w_out)),
        (l3_w_ada, l3_b_ada, l3_g_pre, l3_g_post,
         functools.partial(window_gqa_mixer, w_in=l3_w_in, sink=l3_sink, w_out=l3_w_out)),
    ]
    x_lat, x_ctx = x, ctx
    for i in range(DEPTH):
        w_ada, b_ada, g_pre, g_post, mixer = layers[i]
        need_ctx = i < DEPTH - 1
        sh_l, sc_l, gt_l = modulation(c, w_ada, b_ada)
        sh_c, sc_c, gt_c = modulation(c_ctx, w_ada, b_ada)
        h_l = rmsnorm(x_lat, g_pre) * (1.0 + sc_l[:, None, :]) + sh_l[:, None, :]
        h_c = rmsnorm(x_ctx, g_pre) * (1.0 + sc_c) + sh_c
        y_l, y_c = mixer(h_l, h_c, need_ctx=need_ctx)
        x_lat = x_lat + gt_l[:, None, :] * rmsnorm(y_l, g_post)
        if need_ctx:
            x_ctx = x_ctx + gt_c * rmsnorm(y_c, g_post)
    return x_lat
```

```cpp
#include <hip/hip_runtime.h>
#include <hip/hip_bf16.h>
#include <hip/hip_cooperative_groups.h>
#include <stdint.h>
#include <cstdio>

typedef unsigned short bf16_t;
#define DI __device__ __forceinline__

constexpr int D = 1024, NB = 4, S = 8192, L = 256;
constexpr int NLAT = NB * S, NCTX = NB * L, NT = NLAT + NCTX;
constexpr float EPS = 1e-6f;
constexpr int NCH = 66;

DI int opaque_tid() { int t = threadIdx.x; asm volatile("" : "+v"(t)); return t; }
#define TIDX opaque_tid()
DI int vblock() { const int g = gridDim.x; return (g & 7) ? (int)blockIdx.x : (int)(blockIdx.x & 7) * (g >> 3) + (int)(blockIdx.x >> 3); }
DI float bf2f(bf16_t b) { return __uint_as_float(((unsigned)b) << 16); }
DI bf16_t f2bf(float x) { unsigned u = __float_as_uint(x); u += 0x7fffu + ((u >> 16) & 1u); return (bf16_t)(u >> 16); }
DI float silu_f(float x) { return x / (1.f + __expf(-x)); }
DI float sigmoid_f(float x) { return 1.f / (1.f + __expf(-x)); }
DI int vpos(int row) { return (row & ~12) | ((row & 4) << 1) | ((row & 8) >> 1); }
DI int vpos32(int row) { return (row & ~31) | (((row >> 2) & 3) << 3) | (((row >> 4) & 1) << 2) | (row & 3); }
DI float wave_sum(float v) { for (int o = 32; o > 0; o >>= 1) v += __shfl_xor(v, o); return v; }
DI float wave_max(float v) { for (int o = 32; o > 0; o >>= 1) v = fmaxf(v, __shfl_xor(v, o)); return v; }

constexpr size_t al(size_t x) { return (x + 255) / 256 * 256; }
constexpr int NIN[4] = {2560, 1472, 4112, 2560};
constexpr size_t OFF_WIN0 = 0;
constexpr size_t OFF_WIN1 = OFF_WIN0 + al((size_t)2560 * 1024 * 2);
constexpr size_t OFF_WIN2 = OFF_WIN1 + al((size_t)1472 * 1024 * 2);
constexpr size_t OFF_WIN3 = OFF_WIN2 + al((size_t)4112 * 1024 * 2);
constexpr size_t OFF_WOUT = OFF_WIN3 + al((size_t)2560 * 1024 * 2);
constexpr size_t OFF_WUQ = OFF_WOUT + 4 * al((size_t)1024 * 1024 * 2);
constexpr size_t OFF_WUKV = OFF_WUQ + al((size_t)1536 * 256 * 2);
constexpr size_t OFF_MOD = OFF_WUKV + al((size_t)2048 * 128 * 2);
constexpr size_t OFF_ROPE = OFF_MOD + al((size_t)4 * 5 * 3072 * 4);
constexpr size_t OFF_XC = OFF_ROPE + al((size_t)S * 32 * 8);
constexpr size_t OFF_BAR = OFF_XC + al((size_t)NCTX * D * 4);
constexpr size_t OFF_HB = OFF_BAR + al((size_t)4096 * 4);
constexpr size_t OFF_BIG = OFF_HB + al((size_t)NT * D * 2);
constexpr size_t SZ_T1K = al((size_t)NT * 1024 * 2);
constexpr size_t GQ_QB = OFF_BIG;
constexpr size_t GQ_KB = GQ_QB + SZ_T1K;
constexpr size_t GQ_VT = GQ_KB + al((size_t)NT * 256 * 2);
constexpr size_t GQ_G = GQ_VT + al((size_t)NT * 256 * 2);
constexpr size_t GQ_Y = GQ_G + SZ_T1K;
constexpr size_t GQ_END = GQ_Y + al((size_t)NT * 1024 * 4);
constexpr size_t ML_QB = OFF_BIG;
constexpr size_t ML_KB = ML_QB + al((size_t)NT * 1536 * 2);
constexpr size_t ML_Y = OFF_BIG;
constexpr size_t ML_VT = ML_KB + al((size_t)NT * 1536 * 2);
constexpr size_t ML_G = ML_VT + SZ_T1K;
constexpr size_t ML_QA = ML_G + SZ_T1K;
constexpr size_t ML_KVA = ML_QA + al((size_t)NT * 256 * 2);
constexpr size_t ML_END = ML_KVA + al((size_t)NT * 128 * 2);
constexpr size_t LS_QKRAW = OFF_BIG;
constexpr size_t LS_VT = LS_QKRAW + SZ_T1K;
constexpr size_t LS_OB = LS_VT + SZ_T1K;
constexpr size_t LS_G = LS_OB + SZ_T1K;
constexpr size_t LS_GATES = LS_G + SZ_T1K;
constexpr size_t SZ_PT = al((size_t)2 * 4 * NT * 4);
constexpr size_t LS_CUM = LS_GATES + al((size_t)NT * 16 * 4);
constexpr size_t LS_PM = LS_CUM + SZ_PT;
constexpr size_t LS_BV = LS_PM + SZ_PT;
constexpr size_t LS_EE = LS_BV + SZ_PT;
constexpr int NITEM = NB * 4 * 2 * NCH;
constexpr size_t LS_TOT = LS_EE + SZ_PT;
constexpr size_t LS_MLOC = LS_TOT + al((size_t)NITEM * 4);
constexpr size_t LS_MST = LS_MLOC + al((size_t)NITEM * 4);
constexpr size_t LS_NST = LS_MST + al((size_t)NITEM * 4);
constexpr size_t LS_CST = LS_NST + al((size_t)NITEM * 128 * 4);
constexpr size_t LS_Y = LS_CST;
constexpr size_t LS_END = LS_CST + al((size_t)NITEM * 256 * 128 * 2);
constexpr size_t WS_NEED = (GQ_END > ML_END ? (GQ_END > LS_END ? GQ_END : LS_END) : (ML_END > LS_END ? ML_END : LS_END));
static_assert(WS_NEED <= (size_t)536870912, "workspace over budget");
static_assert((size_t)NT * 1024 * 4 <= (size_t)NITEM * 256 * 128 * 2, "Y alias");

struct P {
  const float *x, *c, *ctx, *cctx;
  const float *w_ada[4], *b_ada[4], *g_pre[4], *g_post[4], *w_in[4], *w_out[4], *sink[4];
  const float *g_qa, *g_kva, *w_uq, *w_ukv, *conv, *b_gate, *g_head;
  float* out;
  char* ws;
};
DI bf16_t* WINT(const P& p, int l) { return (bf16_t*)(p.ws + (l == 0 ? OFF_WIN0 : l == 1 ? OFF_WIN1 : l == 2 ? OFF_WIN2 : OFF_WIN3)); }
DI bf16_t* WOUTT(const P& p, int l) { return (bf16_t*)(p.ws + OFF_WOUT + (size_t)l * al((size_t)1024 * 1024 * 2)); }
DI float* MODV(const P& p, int l, int v) { return (float*)(p.ws + OFF_MOD) + ((size_t)l * 5 + v) * 3072; }
template <typename T> DI T* WSP(const P& p, size_t off) { return (T*)(p.ws + off); }

DI void transpose_tile(const float* __restrict__ src, bf16_t* __restrict__ dst, const float* __restrict__ scale, int K, int N, int tile, float (*t)[68]) {
  const int tilesN = (N + 63) / 64, tn = tile % tilesN, tk = tile / tilesN, tid = TIDX;
  for (int c = tid; c < 1024; c += blockDim.x) {
    const int kk = c >> 4, n4 = (c & 15) * 4, k = tk * 64 + kk, n = tn * 64 + n4;
    float4 v = make_float4(0.f, 0.f, 0.f, 0.f);
    if (n < N) v = *(const float4*)(src + (size_t)k * N + n);
    if (scale) { const float s = scale[k]; v.x *= s; v.y *= s; v.z *= s; v.w *= s; }
    *(float4*)&t[kk][n4] = v;
  }
  __syncthreads();
  for (int d = tid; d < 512; d += blockDim.x) {
    const int nn = d & 63, k8 = (d >> 6) * 8, n = tn * 64 + nn;
    if (n < N) {
      unsigned w[4];
#pragma unroll
      for (int q = 0; q < 4; ++q) w[q] = (unsigned)f2bf(t[k8 + 2 * q][nn]) | ((unsigned)f2bf(t[k8 + 2 * q + 1][nn]) << 16);
      *(uint4*)(dst + (size_t)n * K + tk * 64 + k8) = make_uint4(w[0], w[1], w[2], w[3]);
    }
  }
  __syncthreads();
}
DI int ntiles_tr(int K, int N) { return (K / 64) * ((N + 63) / 64); }

DI void phase_prologue(const P& p, char* smem) {
  float (*t)[68] = (float (*)[68])smem;
  for (int j = 0; j < 10; ++j) {
    const float* src; bf16_t* dst; const float* sc = nullptr; int K, N;
    if (j < 4) { src = p.w_in[j]; dst = WINT(p, j); K = 1024; N = NIN[j]; }
    else if (j < 8) { src = p.w_out[j - 4]; dst = WOUTT(p, j - 4); K = 1024; N = 1024; }
    else if (j == 8) { src = p.w_uq; dst = WSP<bf16_t>(p, OFF_WUQ); sc = p.g_qa; K = 256; N = 1536; }
    else { src = p.w_ukv; dst = WSP<bf16_t>(p, OFF_WUKV); sc = p.g_kva; K = 128; N = 2048; }
    const int nt = ntiles_tr(K, N);
    for (int tile = blockIdx.x; tile < nt; tile += gridDim.x) transpose_tile(src, dst, sc, K, N, tile, t);
  }
  {
    float* red = (float*)smem;
    for (int tile = blockIdx.x; tile < 4 * 48; tile += gridDim.x) {
      const int l = tile / 48, cg = tile % 48, col = cg * 64 + (TIDX & 63), kq = TIDX >> 6;
      float acc[5] = {0, 0, 0, 0, 0};
      const float* w = p.w_ada[l];
      if (kq < 4) for (int k = kq * 256; k < kq * 256 + 256; ++k) {
        const float wv = w[(size_t)k * 3072 + col];
#pragma unroll
        for (int v = 0; v < 5; ++v) { float cv = (v < 4) ? p.c[v * 1024 + k] : p.cctx[k]; acc[v] += silu_f(cv) * wv; }
      }
#pragma unroll
      for (int v = 0; v < 5; ++v) if (kq < 4) red[(kq * 64 + (TIDX & 63)) * 5 + v] = acc[v];
      __syncthreads();
      if (kq == 0) {
#pragma unroll
        for (int v = 0; v < 5; ++v) {
          float s = p.b_ada[l][col];
          for (int q = 0; q < 4; ++q) s += red[(q * 64 + TIDX) * 5 + v];
          MODV(p, l, v)[col] = s;
        }
      }
      __syncthreads();
    }
  }
  {
    float2* rt = WSP<float2>(p, OFF_ROPE);
    for (int i = blockIdx.x * blockDim.x + TIDX; i < S * 32; i += gridDim.x * blockDim.x) {
      const int s = i >> 5, pr = i & 31, f = pr & 15;
      const float pos = (pr < 16) ? (float)(s / 64) : (float)(s % 64);
      const float inv = exp2f(-(float)f * 0.830482023721841f);
      const float ang = pos * inv;
      float tr = ang * 0.15915494309189535f; tr = tr - floorf(tr);
      rt[i] = make_float2(__builtin_amdgcn_cosf(tr), __builtin_amdgcn_sinf(tr));
    }
  }
}

DI void phase_rowwise(const P& p, int l, const bf16_t* __restrict__ Y) {
  const int lane = TIDX & 63, wpb = blockDim.x >> 6;
  bf16_t* H = WSP<bf16_t>(p, OFF_HB);
  float* Xc = WSP<float>(p, OFF_XC);
  float4 gpo[4], gpr[4], gtv[4], shv[4], scv[4];
#pragma unroll
  for (int i = 0; i < 4; ++i) {
    const int c0 = i * 256 + lane * 4;
    gpo[i] = l > 0 ? *(const float4*)(p.g_post[l > 0 ? l - 1 : 0] + c0) : make_float4(0.f, 0.f, 0.f, 0.f);
    gpr[i] = l < 4 ? *(const float4*)(p.g_pre[l < 4 ? l : 0] + c0) : make_float4(0.f, 0.f, 0.f, 0.f);
    gtv[i] = shv[i] = scv[i] = make_float4(0.f, 0.f, 0.f, 0.f);
  }
  int cur_bi = -1;
  for (int row = blockIdx.x * wpb + (TIDX >> 6); row < NT; row += gridDim.x * wpb) {
    const bool isc = row >= NLAT;
    if (l == 4 && isc) continue;
    const int bi = isc ? 4 : row / S;
    if (bi != cur_bi) {
      cur_bi = bi;
#pragma unroll
      for (int i = 0; i < 4; ++i) {
        const int c0 = i * 256 + lane * 4;
        if (l > 0) gtv[i] = *(const float4*)(MODV(p, l - 1, bi) + 2048 + c0);
        if (l < 4) { shv[i] = *(const float4*)(MODV(p, l, bi) + c0); scv[i] = *(const float4*)(MODV(p, l, bi) + 1024 + c0); }
      }
    }
    const float* xs = (l <= 1) ? (isc ? p.ctx + (size_t)(row - NLAT) * D : p.x + (size_t)row * D)
                               : (isc ? Xc + (size_t)(row - NLAT) * D : p.out + (size_t)row * D);
    float4 xv[4];
#pragma unroll
    for (int i = 0; i < 4; ++i) xv[i] = *(const float4*)(xs + i * 256 + lane * 4);
    if (l > 0) {
      float4 yv[4]; float ss = 0;
#pragma unroll
      for (int i = 0; i < 4; ++i) { const ushort4 u = *(const ushort4*)(Y + (size_t)row * D + i * 256 + lane * 4); yv[i] = make_float4(bf2f(u.x), bf2f(u.y), bf2f(u.z), bf2f(u.w)); ss += yv[i].x * yv[i].x + yv[i].y * yv[i].y + yv[i].z * yv[i].z + yv[i].w * yv[i].w; }
      ss = wave_sum(ss);
      const float rs = rsqrtf(ss * (1.f / D) + EPS);
      float* xd = isc ? Xc + (size_t)(row - NLAT) * D : p.out + (size_t)row * D;
#pragma unroll
      for (int i = 0; i < 4; ++i) {
        const int c0 = i * 256 + lane * 4;
        const float4 g = gtv[i], q = gpo[i];
        xv[i].x += g.x * yv[i].x * rs * q.x; xv[i].y += g.y * yv[i].y * rs * q.y; xv[i].z += g.z * yv[i].z * rs * q.z; xv[i].w += g.w * yv[i].w * rs * q.w;
        *(float4*)(xd + c0) = xv[i];
      }
    }
    if (l < 4) {
      float ss = 0;
#pragma unroll
      for (int i = 0; i < 4; ++i) ss += xv[i].x * xv[i].x + xv[i].y * xv[i].y + xv[i].z * xv[i].z + xv[i].w * xv[i].w;
      ss = wave_sum(ss);
      const float rs = rsqrtf(ss * (1.f / D) + EPS);
#pragma unroll
      for (int i = 0; i < 4; ++i) {
        const int c0 = i * 256 + lane * 4;
        const float4 a = shv[i], b = scv[i], g = gpr[i];
        ushort4 o;
        o.x = f2bf(xv[i].x * rs * g.x * (1.f + b.x) + a.x); o.y = f2bf(xv[i].y * rs * g.y * (1.f + b.y) + a.y);
        o.z = f2bf(xv[i].z * rs * g.z * (1.f + b.z) + a.z); o.w = f2bf(xv[i].w * rs * g.w * (1.f + b.w) + a.w);
        *(ushort4*)(H + (size_t)row * D + c0) = o;
      }
    }
  }
}

enum { M_IN_GQA = 0, M_IN_MLA = 1, M_UQ = 2, M_UKV = 3, M_IN_LSTM = 4, M_OUT = 5 };
DI void rope4(const P& p, int row, int d, float* v, bool hp = false, float4 pre = make_float4(1.f, 0.f, 1.f, 0.f)) {
  if (row >= NLAT) return;
  float4 cs;
  if (hp) cs = pre; else { const int s = row & (S - 1); cs = *(const float4*)(WSP<float2>(p, OFF_ROPE) + s * 32 + (d >> 1)); }
  const float a0 = v[0] * cs.x - v[1] * cs.y, a1 = v[0] * cs.y + v[1] * cs.x;
  const float a2 = v[2] * cs.z - v[3] * cs.w, a3 = v[2] * cs.w + v[3] * cs.z;
  v[0] = a0; v[1] = a1; v[2] = a2; v[3] = a3;
}
template <int MODE> DI bool rope_group(int col, int& d) {
  if constexpr (MODE == M_IN_GQA) { d = col & 63; return col < 1280; }
  else if constexpr (MODE == M_IN_MLA) { d = col - 384; return col >= 384 && col < 448; }
  else if constexpr (MODE == M_UQ) { const int dd = col % 192; d = dd - 128; return dd >= 128; }
  else { d = 0; return false; }
}
typedef __attribute__((ext_vector_type(4))) unsigned u32x4_t;
DI unsigned pack2rne(float a, float b) { return (unsigned)f2bf(a) | ((unsigned)f2bf(b) << 16); }
DI void st4(bf16_t* dst, const float* v) { ushort4 o; o.x = f2bf(v[0]); o.y = f2bf(v[1]); o.z = f2bf(v[2]); o.w = f2bf(v[3]); *(ushort4*)dst = o; }
template <int MODE> DI bf16_t* epi_calc(const P& p, int row, int col, float* v, bool hp = false, float4 rpre = make_float4(1.f, 0.f, 1.f, 0.f)) {
  if constexpr (MODE == M_IN_GQA) {
    if (col < 1024) { rope4(p, row, col & 63, v, hp, rpre); for (int i = 0; i < 4; ++i) v[i] *= 0.125f * 1.4426950408889634f;   return WSP<bf16_t>(p, GQ_QB) + (size_t)row * 1024 + col; }
    else if (col < 1280) { const int c = col - 1024; rope4(p, row, c & 63, v, hp, rpre); return WSP<bf16_t>(p, GQ_KB) + (size_t)row * 256 + c; }
    else if (col < 1536) { const int c = col - 1280; bf16_t* vt = WSP<bf16_t>(p, GQ_VT); const int vp = vpos32(row); for (int i = 0; i < 4; ++i) vt[(size_t)(c + i) * NT + vp] = f2bf(v[i]); return nullptr; }
    else { const int c = col - 1536; for (int i = 0; i < 4; ++i) v[i] = silu_f(v[i]); return WSP<bf16_t>(p, GQ_G) + (size_t)row * 1024 + c; }
  } else if constexpr (MODE == M_IN_MLA) {
    if (col < 256) return WSP<bf16_t>(p, ML_QA) + (size_t)row * 256 + col;
    else if (col < 384) return WSP<bf16_t>(p, ML_KVA) + (size_t)row * 128 + (col - 256);
    else if (col < 448) { const int d = col - 384; rope4(p, row, d, v, hp, rpre); bf16_t* kb = WSP<bf16_t>(p, ML_KB) + (size_t)row * 1536 + 128 + d; for (int h = 0; h < 8; ++h) st4(kb + h * 192, v); return nullptr; }
    else { const int c = col - 448; for (int i = 0; i < 4; ++i) v[i] = silu_f(v[i]); return WSP<bf16_t>(p, ML_G) + (size_t)row * 1024 + c; }
  } else if constexpr (MODE == M_UQ) {
    const int d = col % 192;
    if (d >= 128) rope4(p, row, d - 128, v, hp, rpre);
    for (int i = 0; i < 4; ++i) v[i] *= 0.07216878364870323f * 1.4426950408889634f;
    return WSP<bf16_t>(p, ML_QB) + (size_t)row * 1536 + col;
  } else if constexpr (MODE == M_UKV) {
    const int h = col >> 8, e = col & 255;
    if (e < 128) return WSP<bf16_t>(p, ML_KB) + (size_t)row * 1536 + h * 192 + e;
    else { bf16_t* vt = WSP<bf16_t>(p, ML_VT); const int vp = vpos32(row); for (int i = 0; i < 4; ++i) vt[(size_t)(h * 128 + e - 128 + i) * NT + vp] = f2bf(v[i]); return nullptr; }
  } else if constexpr (MODE == M_IN_LSTM) {
    if (col < 1024) return WSP<bf16_t>(p, LS_QKRAW) + (size_t)row * 1024 + col;
    else if (col < 2048) { bf16_t* vt = WSP<bf16_t>(p, LS_VT); const int vp = vpos(row); for (int i = 0; i < 4; ++i) vt[(size_t)(col - 1024 + i) * NT + vp] = f2bf(v[i]); return nullptr; }
    else if (col < 3072) { for (int i = 0; i < 4; ++i) v[i] = sigmoid_f(v[i]); return WSP<bf16_t>(p, LS_OB) + (size_t)row * 1024 + (col - 2048); }
    else if (col < 4096) { for (int i = 0; i < 4; ++i) v[i] = silu_f(v[i]); return WSP<bf16_t>(p, LS_G) + (size_t)row * 1024 + (col - 3072); }
    else { float* g = WSP<float>(p, LS_GATES) + (size_t)row * 16 + (col - 4096); for (int i = 0; i < 4; ++i) g[i] = v[i] + p.b_gate[col - 4096 + i]; return nullptr; }
  }
  return nullptr;
}
template <int MODE> DI void epi(const P& p, int row, int col, float* v) { bf16_t* d = epi_calc<MODE>(p, row, col, v); if (d) st4(d, v); }
template <int MODE> DI void epi8(const P& p, bf16_t* Y, int row, int col, float* v, bool hp = false, float4 rp0 = make_float4(1.f, 0.f, 1.f, 0.f), float4 rp1 = make_float4(1.f, 0.f, 1.f, 0.f)) {
  bf16_t *d0, *d1;
  if constexpr (MODE == M_OUT) { d0 = Y + (size_t)row * 1024 + col; d1 = d0 + 4; }
  else { d0 = epi_calc<MODE>(p, row, col, v, hp, rp0); d1 = epi_calc<MODE>(p, row, col + 4, v + 4, hp, rp1); }
  if (d0 != nullptr && d1 == d0 + 4) {
    u32x4_t w = {pack2rne(v[0], v[1]), pack2rne(v[2], v[3]), pack2rne(v[4], v[5]), pack2rne(v[6], v[7])};
    *(u32x4_t*)d0 = w;
  } else { if (d0) st4(d0, v); if (d1) st4(d1, v + 4); }
}
DI void epi_out(bf16_t* Y, int row, int col, const float* v) { st4(Y + (size_t)row * 1024 + col, v); }

DI void unpack8(uint4 a, float* f) {
  f[0] = __uint_as_float(a.x << 16); f[1] = __uint_as_float(a.x & 0xffff0000u); f[2] = __uint_as_float(a.y << 16); f[3] = __uint_as_float(a.y & 0xffff0000u);
  f[4] = __uint_as_float(a.z << 16); f[5] = __uint_as_float(a.z & 0xffff0000u); f[6] = __uint_as_float(a.w << 16); f[7] = __uint_as_float(a.w & 0xffff0000u);
}
template <int MODE, bool ROWSCALE>
__global__ __launch_bounds__(256) void k_gemm_naive(P p, const bf16_t* __restrict__ A, int lda, const bf16_t* __restrict__ Wt, int K, int N, int M, bf16_t* Y) {
  const int n4 = N >> 2; const long total = (long)M * n4;
  for (long idx = (long)blockIdx.x * 256 + TIDX; idx < total; idx += (long)gridDim.x * 256) {
    const int col = (int)(idx % n4) * 4, row = (int)(idx / n4);
    float acc[4] = {0, 0, 0, 0}, ss = 0;
    const bf16_t* a = A + (size_t)row * lda; const bf16_t* w = Wt + (size_t)col * K;
    for (int k = 0; k < K; k += 8) {
      float af[8], wf[8]; unpack8(*(const uint4*)(a + k), af);
      if (ROWSCALE) { for (int j = 0; j < 8; ++j) ss += af[j] * af[j]; }
#pragma unroll
      for (int i = 0; i < 4; ++i) { unpack8(*(const uint4*)(w + (size_t)i * K + k), wf); for (int j = 0; j < 8; ++j) acc[i] += af[j] * wf[j]; }
    }
    if (ROWSCALE) { const float rs = rsqrtf(ss / (float)K + EPS); for (int i = 0; i < 4; ++i) acc[i] *= rs; }
    if constexpr (MODE == M_OUT) epi_out(Y, row, col, acc); else epi<MODE>(p, row, col, acc);
  }
}

template <int KIND>
__global__ __launch_bounds__(256) void k_attn_naive(P p, const float* __restrict__ sink, int row_begin, int row_end) {
  constexpr int DQK = KIND ? 192 : 64, DV = KIND ? 128 : 64, HQ = KIND ? 8 : 16, GRP = KIND ? 1 : 4;
  constexpr int LDQ = HQ * DQK, LDK = (HQ / GRP) * DQK;
  const bf16_t* Qb = WSP<bf16_t>(p, KIND ? ML_QB : GQ_QB); const bf16_t* Kb = WSP<bf16_t>(p, KIND ? ML_KB : GQ_KB);
  const bf16_t* Vt = WSP<bf16_t>(p, KIND ? ML_VT : GQ_VT); const bf16_t* G = WSP<bf16_t>(p, KIND ? ML_G : GQ_G);
  bf16_t* O = WSP<bf16_t>(p, OFF_HB);
  __shared__ float qs[4][DQK];
  const int lane = TIDX & 63, wv = TIDX >> 6;
  const long nitems = (long)(row_end - row_begin) * HQ;
  for (long it = (long)blockIdx.x * 4 + wv; it < nitems; it += (long)gridDim.x * 4) {
    const int row = row_begin + (int)(it / HQ), h = (int)(it % HQ), kvh = h / GRP;
    const bool isc = row >= NLAT;
    int a0 = 0, nA = 0, c0;
    if (!isc) { const int b = row / S, s = row % S; c0 = NLAT + b * L;
      if (KIND == 0) { int lo = s - 128 < 0 ? 0 : s - 128, hi = s + 129 > S ? S : s + 129; a0 = b * S + lo; nA = hi - lo; } else { a0 = b * S; nA = S; } }
    else c0 = NLAT + ((row - NLAT) / L) * L;
    const int nk = nA + L;
    for (int d = lane; d < DQK; d += 64) qs[wv][d] = bf2f(Qb[(size_t)row * LDQ + h * DQK + d]);
    __builtin_amdgcn_s_waitcnt(0); __builtin_amdgcn_wave_barrier();
    float m = -1e30f;
    for (int j = lane; j < nk; j += 64) {
      const int kr = j < nA ? a0 + j : c0 + (j - nA);
      const bf16_t* kp = Kb + (size_t)kr * LDK + kvh * DQK; float s = 0;
      for (int d = 0; d < DQK; d += 8) { float kf[8]; unpack8(*(const uint4*)(kp + d), kf); for (int e = 0; e < 8; ++e) s += qs[wv][d + e] * kf[e]; }
      m = fmaxf(m, s);
    }
    m = wave_max(m);
    float lsum = 0;
    if (KIND == 0) { const float sk = sink[h] * 1.4426950408889634f; m = fmaxf(m, sk); }
    float acc[DV];
#pragma unroll
    for (int d = 0; d < DV; ++d) acc[d] = 0;
    for (int j = lane; j < nk; j += 64) {
      const int kr = j < nA ? a0 + j : c0 + (j - nA);
      const bf16_t* kp = Kb + (size_t)kr * LDK + kvh * DQK; float s = 0;
      for (int d = 0; d < DQK; d += 8) { float kf[8]; unpack8(*(const uint4*)(kp + d), kf); for (int e = 0; e < 8; ++e) s += qs[wv][d + e] * kf[e]; }
      const float pe = exp2f(s - m); lsum += pe;
      const bf16_t* vp = Vt + (size_t)(kvh * DV) * NT + vpos32(kr);
#pragma unroll
      for (int d = 0; d < DV; ++d) acc[d] += pe * bf2f(vp[(size_t)d * NT]);
    }
    lsum = wave_sum(lsum);
    if (KIND == 0) lsum += exp2f(sink[h] * 1.4426950408889634f - m);
    const float inv = 1.f / lsum;
    float o0 = 0, o1 = 0;
#pragma unroll
    for (int d = 0; d < DV; ++d) { const float t = wave_sum(acc[d]); if ((d & 63) == lane) { if (d < 64) o0 = t; else o1 = t; } }
    { const size_t oi = (size_t)row * 1024 + h * DV + lane; O[oi] = f2bf(o0 * inv * bf2f(G[oi])); if (DV > 64) O[oi + 64] = f2bf(o1 * inv * bf2f(G[oi + 64])); }
    __builtin_amdgcn_wave_barrier();
  }
}

DI int chunk_base(int b, int dir, int c) {
  if (c < 2) { const int blk = dir ? 1 - c : c; return NLAT + b * L + blk * 128; }
  const int cc = c - 2, blk = dir ? 63 - cc : cc; return b * S + blk * 128;
}
DI void phase_conv(const P& p) {
  const bf16_t* src = WSP<bf16_t>(p, LS_QKRAW); bf16_t* dst = WSP<bf16_t>(p, OFF_HB);
  constexpr int RCH = 33, NCHK = NT / RCH;
  static_assert(NCHK * RCH == NT, "conv chunking");
  const int tid = TIDX, cg = tid & 127, c0 = cg * 8, grp = tid >> 7, ngrp = blockDim.x >> 7;
  float wt[5][8];
#pragma unroll
  for (int j = 0; j < 5; ++j) { const float4 a = *(const float4*)(p.conv + j * 1024 + c0), b = *(const float4*)(p.conv + j * 1024 + c0 + 4); wt[j][0] = a.x; wt[j][1] = a.y; wt[j][2] = a.z; wt[j][3] = a.w; wt[j][4] = b.x; wt[j][5] = b.y; wt[j][6] = b.z; wt[j][7] = b.w; }
  const float osc = c0 >= 512 ? 0.08838834764831845f : 1.f;
  for (int chunk = blockIdx.x * ngrp + grp; chunk < NCHK; chunk += gridDim.x * ngrp) {
    const int r0 = chunk * RCH;
    float win[5][8];
#define CV_LOAD(dstv, r_) do { int rr_ = (r_); rr_ = rr_ < 0 ? 0 : (rr_ >= NT ? NT - 1 : rr_); float f_[8]; unpack8(*(const uint4*)(src + (size_t)rr_ * 1024 + c0), f_); \
      _Pragma("unroll") for (int e = 0; e < 8; ++e) dstv[e] = f_[e]; } while (0)
    CV_LOAD(win[0], r0 - 2); CV_LOAD(win[1], r0 - 1); CV_LOAD(win[2], r0); CV_LOAD(win[3], r0 + 1);
#pragma unroll 1
    for (int sb = 0; sb < 3; ++sb) {
      uint4 q[11];
#pragma unroll
      for (int i = 0; i < 11; ++i) { int rr = r0 + sb * 11 + i + 2; rr = rr >= NT ? NT - 1 : rr; q[i] = *(const uint4*)(src + (size_t)rr * 1024 + c0); }
#pragma unroll
      for (int i = 0; i < 11; ++i) {
        const int row = r0 + sb * 11 + i;
        { float f_[8]; unpack8(q[i], f_);
#pragma unroll
          for (int e = 0; e < 8; ++e) win[4][e] = f_[e]; }
        int lo, hi;
        if (row < NLAT) { lo = (row / S) * S; hi = lo + S; } else { lo = NLAT + ((row - NLAT) / L) * L; hi = lo + L; }
        float acc[8];
#pragma unroll
        for (int e = 0; e < 8; ++e) acc[e] = 0.f;
#pragma unroll
        for (int j = 0; j < 5; ++j) {
          const int r = row + j - 2;
          const float mk = (r >= lo && r < hi) ? 1.f : 0.f;
#pragma unroll
          for (int e = 0; e < 8; ++e) acc[e] += mk * win[j][e] * wt[j][e];
        }
        u32x4_t o;
#pragma unroll
        for (int qq = 0; qq < 4; ++qq) o[qq] = pack2rne(silu_f(acc[2 * qq]) * osc, silu_f(acc[2 * qq + 1]) * osc);
        *(u32x4_t*)(dst + (size_t)row * 1024 + c0) = o;
#pragma unroll
        for (int j = 0; j < 4; ++j)
#pragma unroll
          for (int e = 0; e < 8; ++e) win[j][e] = win[j + 1][e];
      }
    }
  }
}
DI void phase_prep(const P& p) {
  const float* gates = WSP<float>(p, LS_GATES);
  float *CUM = WSP<float>(p, LS_CUM), *PM = WSP<float>(p, LS_PM), *BV = WSP<float>(p, LS_BV), *EE = WSP<float>(p, LS_EE);
  float *TOT = WSP<float>(p, LS_TOT), *MLOC = WSP<float>(p, LS_MLOC);
  const int lane = TIDX & 63, wpb = blockDim.x >> 6;
  for (int it = blockIdx.x * wpb + (TIDX >> 6); it < NITEM; it += gridDim.x * wpb) {
    const int c = it % NCH, dir = (it / NCH) & 1, h = (it / (NCH * 2)) & 3, b = it / (NCH * 8);
    const int base = chunk_base(b, dir, c);
    const int r0 = base + (dir ? 127 - lane : lane), r1 = base + (dir ? 63 - lane : 64 + lane);
    const float f0 = gates[(size_t)r0 * 16 + (2 * dir + 1) * 4 + h], f1 = gates[(size_t)r1 * 16 + (2 * dir + 1) * 4 + h];
    const float i0 = gates[(size_t)r0 * 16 + (2 * dir) * 4 + h], i1 = gates[(size_t)r1 * 16 + (2 * dir) * 4 + h];
    float c0v = fminf(f0, 0.f) - log1pf(__expf(-fabsf(f0))), c1v = fminf(f1, 0.f) - log1pf(__expf(-fabsf(f1)));
    for (int o = 1; o < 64; o <<= 1) { float t0 = __shfl_up(c0v, o), t1 = __shfl_up(c1v, o); if (lane >= o) { c0v += t0; c1v += t1; } }
    c1v += __shfl(c0v, 63);
    const float tot = __shfl(c1v, 63);
    const float b0 = i0 - c0v, b1 = i1 - c1v;
    float p0 = b0, p1 = b1;
    for (int o = 1; o < 64; o <<= 1) { float t0 = __shfl_up(p0, o), t1 = __shfl_up(p1, o); if (lane >= o) { p0 = fmaxf(p0, t0); p1 = fmaxf(p1, t1); } }
    p1 = fmaxf(p1, __shfl(p0, 63));
    const float bmax = __shfl(p1, 63);
    const size_t o0 = ((size_t)dir * 4 + h) * NT + r0, o1 = ((size_t)dir * 4 + h) * NT + r1;
    CUM[o0] = c0v; CUM[o1] = c1v; PM[o0] = p0; PM[o1] = p1; BV[o0] = b0; BV[o1] = b1; EE[o0] = __expf(b0 - bmax); EE[o1] = __expf(b1 - bmax);
    if (lane == 0) { TOT[it] = tot; MLOC[it] = tot + bmax; }
  }
}
__global__ __launch_bounds__(256) void k_lstm_scan_naive(P p) {
  const bf16_t* QK = WSP<bf16_t>(p, OFF_HB); const bf16_t* Vt = WSP<bf16_t>(p, LS_VT);
  const float *EE = WSP<float>(p, LS_EE), *TOT = WSP<float>(p, LS_TOT), *MLOC = WSP<float>(p, LS_MLOC);
  float *MST = WSP<float>(p, LS_MST), *NST = WSP<float>(p, LS_NST); bf16_t* CST = WSP<bf16_t>(p, LS_CST);
  const long idx = (long)blockIdx.x * 256 + TIDX;
  const int k = idx & 127, v = (idx >> 7) & 255, bhd = (int)(idx >> 15), dir = bhd & 1, h = (bhd >> 1) & 3, b = bhd >> 3;
  float C = 0, n = 0, m = -1e30f;
  for (int c = 0; c < NCH; ++c) {
    const int it = bhd * NCH + c, base = chunk_base(b, dir, c);
    CST[((size_t)it * 256 + v) * 128 + k] = f2bf(C);
    if (v == 0) { NST[(size_t)it * 128 + k] = n; if (k == 0) MST[it] = m; }
    const float tot = TOT[it], ml = MLOC[it], mn = fmaxf(tot + m, ml), a = __expf(tot + m - mn), bb = __expf(ml - mn);
    float acc = 0, nacc = 0;
    const float* ee = EE + ((size_t)dir * 4 + h) * NT + base;
    const bf16_t* vp = Vt + (size_t)(h * 256 + v) * NT; const bf16_t* kp = QK + (size_t)base * 1024 + 512 + h * 128 + k;
    for (int t = 0; t < 128; ++t) { const float e = ee[t], kv = bf2f(kp[(size_t)t * 1024]); acc += e * bf2f(vp[vpos(base + t)]) * kv; nacc += e * kv; }
    C = a * C + bb * acc; n = a * n + bb * nacc; m = mn;
  }
}
__global__ __launch_bounds__(256) void k_lstm_out_naive(P p) {
  extern __shared__ float sm[];
  float (*Sp)[128][129] = (float (*)[128][129])sm;
  float* den = sm + 2 * 128 * 129; float* at = den + 256; float* fl = at + 256; float* mxs = fl + 256;
  const bf16_t* QK = WSP<bf16_t>(p, OFF_HB); const bf16_t* Vt = WSP<bf16_t>(p, LS_VT);
  const float *CUM = WSP<float>(p, LS_CUM), *PM = WSP<float>(p, LS_PM), *BV = WSP<float>(p, LS_BV);
  const float *MST = WSP<float>(p, LS_MST), *NST = WSP<float>(p, LS_NST); const bf16_t* CST = WSP<bf16_t>(p, LS_CST);
  bf16_t* HS = WSP<bf16_t>(p, LS_QKRAW);
  const int tid = TIDX;
  const int mb = blockIdx.x % NCH, h = (blockIdx.x / NCH) & 3, b = blockIdx.x / (NCH * 4);
  const int base = mb < 2 ? NLAT + b * L + mb * 128 : b * S + (mb - 2) * 128;
  int its[2];
  for (int dir = 0; dir < 2; ++dir) { const int c = mb < 2 ? (dir ? 1 - mb : mb) : 2 + (dir ? 63 - (mb - 2) : mb - 2); its[dir] = ((b * 4 + h) * 2 + dir) * NCH + c; }
  { const int dir = tid >> 7, i = tid & 127; const float mst = MST[its[dir]]; const size_t o = ((size_t)dir * 4 + h) * NT + base + i;
    const float mx = fmaxf(mst, PM[o]); mxs[tid] = mx; at[tid] = __expf(mst - mx); fl[tid] = __expf(-CUM[o] - mx); }
  __syncthreads();
  for (int e = tid; e < 2 * 128 * 128; e += 256) {
    const int dir = e >> 14, i = (e >> 7) & 127, j = e & 127;
    float s = 0;
    if (dir ? (j >= i) : (j <= i)) {
      const bf16_t* qp = QK + (size_t)(base + i) * 1024 + h * 128; const bf16_t* kp = QK + (size_t)(base + j) * 1024 + 512 + h * 128;
      for (int d = 0; d < 128; d += 8) { float qf[8], kf[8]; unpack8(*(const uint4*)(qp + d), qf); unpack8(*(const uint4*)(kp + d), kf); for (int u = 0; u < 8; ++u) s += qf[u] * kf[u]; }
      s *= __expf(BV[((size_t)dir * 4 + h) * NT + base + j] - mxs[dir * 128 + i]);
    }
    Sp[dir][i][j] = s;
  }
  __syncthreads();
  { const int dir = tid >> 7, i = tid & 127; float s = 0; for (int j = 0; j < 128; ++j) s += Sp[dir][i][j];
    float nq = 0; const bf16_t* qp = QK + (size_t)(base + i) * 1024 + h * 128; const float* ns = NST + (size_t)its[dir] * 128;
    for (int k = 0; k < 128; ++k) nq += ns[k] * bf2f(qp[k]);
    den[tid] = s + at[tid] * nq; }
  __syncthreads();
  { const int v = tid; const bf16_t* vp = Vt + (size_t)(h * 256 + v) * NT;
    for (int i = 0; i < 128; ++i) {
      float hs = 0; const bf16_t* qp = QK + (size_t)(base + i) * 1024 + h * 128;
      for (int dir = 0; dir < 2; ++dir) {
        float num = 0; for (int j = 0; j < 128; ++j) num += Sp[dir][i][j] * bf2f(vp[vpos(base + j)]);
        float cq = 0; const bf16_t* cp = CST + ((size_t)its[dir] * 256 + v) * 128;
        for (int k = 0; k < 128; k += 8) { float cf[8], qf[8]; unpack8(*(const uint4*)(cp + k), cf); unpack8(*(const uint4*)(qp + k), qf); for (int u = 0; u < 8; ++u) cq += cf[u] * qf[u]; }
        num += at[dir * 128 + i] * cq;
        hs += num / fmaxf(fabsf(den[dir * 128 + i]), fl[dir * 128 + i]);
      }
      HS[(size_t)(base + i) * 1024 + h * 256 + v] = f2bf(hs);
    } }
}
__global__ __launch_bounds__(256) void k_lstm_finish_naive(P p) {
  const bf16_t* HS = WSP<bf16_t>(p, LS_QKRAW); const bf16_t* OB = WSP<bf16_t>(p, LS_OB); const bf16_t* G = WSP<bf16_t>(p, LS_G); bf16_t* O = WSP<bf16_t>(p, OFF_HB);
  const int lane = TIDX & 63;
  for (int row = blockIdx.x * 4 + (TIDX >> 6); row < NT; row += gridDim.x * 4) {
    const size_t o = (size_t)row * 1024 + lane * 16; float hh[16], ss = 0;
    for (int i = 0; i < 16; ++i) { hh[i] = bf2f(HS[o + i]) * bf2f(OB[o + i]); ss += hh[i] * hh[i]; }
    for (int q = 1; q < 16; q <<= 1) ss += __shfl_xor(ss, q);
    const float rs = rsqrtf(ss * (1.f / 256) + EPS);
    for (int i = 0; i < 16; ++i) O[o + i] = f2bf(hh[i] * rs * p.g_head[lane * 16 + i] * bf2f(G[o + i]));
  }
}

typedef __attribute__((ext_vector_type(8))) short bf16x8;
typedef __attribute__((ext_vector_type(16))) float f32x16;
typedef __attribute__((ext_vector_type(4))) float f32x4;
typedef __bf16 bf2_t __attribute__((ext_vector_type(2)));
typedef float f2_t __attribute__((ext_vector_type(2)));
typedef __attribute__((ext_vector_type(4))) unsigned u32x4;
#define MFMA(a, b, c) __builtin_amdgcn_mfma_f32_32x32x16_bf16((a), (b), (c), 0, 0, 0)
DI unsigned pack2(float a, float b) { f2_t v = {a, b}; bf2_t r = __builtin_convertvector(v, bf2_t); return __builtin_bit_cast(unsigned, r); }
constexpr int SMEM_BYTES = 147456;
constexpr int GT_F = 128, GT_T = 256, GBK = 64, G_STAGE = (GT_F + GT_T) * 128;
static_assert(3 * G_STAGE <= SMEM_BYTES, "gemm lds");
#define GLDS16(gp, lp) __builtin_amdgcn_global_load_lds((const unsigned*)(gp), (unsigned __attribute__((address_space(3)))*)(lp), 16, 0, 0)
#define RAW_BARRIER() do { asm volatile("s_waitcnt lgkmcnt(0)" ::: "memory"); __builtin_amdgcn_s_barrier(); asm volatile("" ::: "memory"); } while (0)
#define WAIT_VM(n) asm volatile("s_waitcnt vmcnt(" #n ")" ::: "memory")

template <int MODE, bool ROWSCALE>
DI void phase_gemm(const P& p, const bf16_t* __restrict__ A, int lda, const bf16_t* __restrict__ Wt, int K, int N, int M, bf16_t* Y, char* smem) {
  const int tid = TIDX, lane = tid & 63, w = __builtin_amdgcn_readfirstlane(tid >> 6), r = lane & 31, h = lane >> 5;
  const int wf = w & 1, wt = w >> 1;
  const int ntn = (N + GT_F - 1) / GT_F, ntm = M / GT_T, ntiles = ntn * ntm, nk = K / GBK;
  const int lrow = lane >> 3, lcp = lane & 7;
  const int r16 = lane & 15, kq = lane >> 4;
  const int fsw = (r16 >> 1) & 7;
  const int G = gridDim.x, first = vblock();
  const int nmy = first < ntiles ? (ntiles - 1 - first) / G + 1 : 0, total = nmy * nk;
  const bf16_t* gw[2]; const bf16_t* ga[4];
#define G_SETPTR(tile_) do { const int sr_ = (tile_) / (4 * ntn), rem_ = (tile_) - sr_ * 4 * ntn, n0_ = (rem_ >> 2) * GT_F, m0_ = (sr_ * 4 + (rem_ & 3)) * GT_T; \
    _Pragma("unroll") for (int i = 0; i < 2; ++i) { const int row = 8 * (w + 8 * i) + lrow; \
      const int prow = (row & 64) | (((row >> 5) & 1) << 5) | (((row >> 2) & 3) << 3) | (((row >> 4) & 1) << 2) | (row & 3);     \
      int n = n0_ + prow; n = n < N ? n : N - 1; gw[i] = Wt + (size_t)n * K + ((lcp ^ ((row >> 1) & 7)) << 3); } \
    _Pragma("unroll") for (int i = 0; i < 4; ++i) { const int row = 8 * (w + 8 * i) + lrow; ga[i] = A + (size_t)(m0_ + row) * lda + ((lcp ^ ((row >> 1) & 7)) << 3); } } while (0)
#define G_ISSUE() do { char* st_ = smem + ibuf * G_STAGE; \
    _Pragma("unroll") for (int i = 0; i < 2; ++i) GLDS16(gw[i] + is_kt * GBK, st_ + (w + 8 * i) * 1024); \
    _Pragma("unroll") for (int i = 0; i < 4; ++i) GLDS16(ga[i] + is_kt * GBK, st_ + GT_F * 128 + (w + 8 * i) * 1024); \
    ibuf = ibuf == 2 ? 0 : ibuf + 1; \
    if (++is_kt == nk) { is_kt = 0; is_tile += G; if (is_tile < ntiles) G_SETPTR(is_tile); } } while (0)
  int is_tile = first, is_kt = 0, ibuf = 0, buf = 0, g = 0;
  if (total > 0) { G_SETPTR(first); G_ISSUE(); if (total > 1) G_ISSUE(); }
  for (int tile = first; tile < ntiles; tile += G) {
    const int sr = tile / (4 * ntn), rem = tile - sr * 4 * ntn, tn = rem >> 2, tm = sr * 4 + (rem & 3), n0 = tn * GT_F, m0 = tm * GT_T;
    f32x4 acc[4][4];
#pragma unroll
    for (int i = 0; i < 4; ++i)
#pragma unroll
      for (int j = 0; j < 4; ++j)
#pragma unroll
        for (int e = 0; e < 4; ++e) acc[i][j][e] = 0.f;
    float ssq[4] = {0.f, 0.f, 0.f, 0.f};
    bool vtile = false;
    if constexpr (MODE == M_IN_GQA) vtile = n0 >= 1280 && n0 < 1536;
    if constexpr (MODE == M_UKV) vtile = (n0 & 255) == 128;
    if constexpr (MODE == M_IN_LSTM) vtile = n0 >= 1024 && n0 < 2048;
#define G_KLOOP(SWAP_) \
    _Pragma("clang loop unroll(disable)") \
    for (int kt = 0; kt < nk; ++kt, ++g) { \
      if (g + 1 < total) WAIT_VM(6); else WAIT_VM(0); \
      RAW_BARRIER(); \
      if (g + 2 < total) G_ISSUE(); \
      const char* Ws = smem + buf * G_STAGE + (wf * 64 + r16) * 128; const char* As = smem + buf * G_STAGE + (GT_F + wt * 64 + r16) * 128; \
      _Pragma("unroll") for (int ks = 0; ks < 2; ++ks) { \
        const int co = ((4 * ks + kq) ^ fsw) << 4; \
        bf16x8 wfr[4], afr[4]; \
        _Pragma("unroll") for (int i = 0; i < 4; ++i) wfr[i] = *(const bf16x8*)(Ws + i * 16 * 128 + co); \
        _Pragma("unroll") for (int i = 0; i < 4; ++i) afr[i] = *(const bf16x8*)(As + i * 16 * 128 + co); \
        if constexpr (ROWSCALE) { _Pragma("unroll") for (int i = 0; i < 4; ++i) _Pragma("unroll") for (int j = 0; j < 8; ++j) { const float f = bf2f((bf16_t)afr[i][j]); ssq[i] += f * f; } } \
        _Pragma("unroll") for (int i = 0; i < 4; ++i) _Pragma("unroll") for (int j = 0; j < 4; ++j) \
          acc[i][j] = SWAP_ ? __builtin_amdgcn_mfma_f32_16x16x32_bf16(afr[j], wfr[i], acc[i][j], 0, 0, 0) : __builtin_amdgcn_mfma_f32_16x16x32_bf16(wfr[i], afr[j], acc[i][j], 0, 0, 0); \
      } \
      buf = buf == 2 ? 0 : buf + 1; \
    }
    if (vtile) { G_KLOOP(true) } else { G_KLOOP(false) }
    float rs[4] = {1.f, 1.f, 1.f, 1.f};
    if constexpr (ROWSCALE) {
#pragma unroll
      for (int i = 0; i < 4; ++i) { float t = ssq[i]; t += __shfl_xor(t, 16); t += __shfl_xor(t, 32); rs[i] = rsqrtf(t / (float)K + EPS); }
    }
    if (vtile) {
      bf16_t* vt = WSP<bf16_t>(p, MODE == M_IN_GQA ? GQ_VT : MODE == M_UKV ? ML_VT : LS_VT);
      const int tok0 = m0 + wt * 64;
#pragma unroll
      for (int fi = 0; fi < 4; ++fi) {
        const int col = n0 + wf * 64 + 32 * (fi >> 1) + 8 * ((r16 >> 2) & 3) + 4 * (fi & 1) + (r16 & 3);
        const int vr = MODE == M_IN_GQA ? col - 1280 : MODE == M_UKV ? (col >> 8) * 128 + (col & 255) - 128 : col - 1024;
        bf16_t* vrow = vt + (size_t)vr * NT + tok0;
        float sc[4][4];
#pragma unroll
        for (int ti = 0; ti < 4; ++ti)
#pragma unroll
          for (int r = 0; r < 4; ++r) sc[ti][r] = ROWSCALE ? __shfl(rs[ti], 4 * kq + r) : 1.f;
        if constexpr (MODE == M_IN_LSTM) {
          const int sw = ((kq & 1) << 1) | (kq >> 1);
#pragma unroll
          for (int ti = 0; ti < 4; ++ti) { float v[4] = {acc[fi][ti][0] * sc[ti][0], acc[fi][ti][1] * sc[ti][1], acc[fi][ti][2] * sc[ti][2], acc[fi][ti][3] * sc[ti][3]}; st4(vrow + 16 * ti + 4 * sw, v); }
        } else {
#pragma unroll
          for (int tp = 0; tp < 2; ++tp) {
            u32x4_t wv = {pack2rne(acc[fi][2 * tp][0] * sc[2 * tp][0], acc[fi][2 * tp][1] * sc[2 * tp][1]), pack2rne(acc[fi][2 * tp][2] * sc[2 * tp][2], acc[fi][2 * tp][3] * sc[2 * tp][3]),
                          pack2rne(acc[fi][2 * tp + 1][0] * sc[2 * tp + 1][0], acc[fi][2 * tp + 1][1] * sc[2 * tp + 1][1]), pack2rne(acc[fi][2 * tp + 1][2] * sc[2 * tp + 1][2], acc[fi][2 * tp + 1][3] * sc[2 * tp + 1][3])};
            *(u32x4_t*)(vrow + 32 * tp + 8 * kq) = wv;
          }
        }
      }
      continue;
    }
    float4 rp[4][2][2];
    bool roped[2]; int rd[2];
#pragma unroll
    for (int fp = 0; fp < 2; ++fp) { const int col = n0 + wf * 64 + fp * 32 + 8 * kq; roped[fp] = rope_group<MODE>(col, rd[fp]) && col < N; }
    if (__any(roped[0] || roped[1])) {
#pragma unroll
      for (int fp = 0; fp < 2; ++fp)
#pragma unroll
        for (int ti = 0; ti < 4; ++ti) {
          const int row = m0 + wt * 64 + ti * 16 + r16;
          const float4* t4 = (const float4*)(WSP<float2>(p, OFF_ROPE) + (row < NLAT ? (row & (S - 1)) : 0) * 32 + (roped[fp] ? (rd[fp] >> 1) : 0));
          rp[ti][fp][0] = t4[0]; rp[ti][fp][1] = t4[1];
        }
    } else {
#pragma unroll
      for (int fp = 0; fp < 2; ++fp)
#pragma unroll
        for (int ti = 0; ti < 4; ++ti) { rp[ti][fp][0] = make_float4(1.f, 0.f, 1.f, 0.f); rp[ti][fp][1] = make_float4(1.f, 0.f, 1.f, 0.f); }
    }
#pragma unroll
    for (int ti = 0; ti < 4; ++ti) {
      const int row = m0 + wt * 64 + ti * 16 + r16;
#pragma unroll
      for (int fp = 0; fp < 2; ++fp) {
        const int col = n0 + wf * 64 + fp * 32 + 8 * kq;
        if (col < N) {
          float v[8] = {acc[2 * fp][ti][0] * rs[ti], acc[2 * fp][ti][1] * rs[ti], acc[2 * fp][ti][2] * rs[ti], acc[2 * fp][ti][3] * rs[ti],
                        acc[2 * fp + 1][ti][0] * rs[ti], acc[2 * fp + 1][ti][1] * rs[ti], acc[2 * fp + 1][ti][2] * rs[ti], acc[2 * fp + 1][ti][3] * rs[ti]};
          epi8<MODE>(p, Y, row, col, v, roped[fp], rp[ti][fp][0], rp[ti][fp][1]);
        }
      }
    }
  }
  __syncthreads();
}

#define MFMA16(a, b, c) __builtin_amdgcn_mfma_f32_16x16x32_bf16((a), (b), (c), 0, 0, 0)
template <int KIND>
DI void phase_attn(const P& p, const float* __restrict__ sink, bool with_ctx, char* smem) {
  constexpr int DQK = KIND ? 192 : 64, DV = KIND ? 128 : 64, HQ = KIND ? 8 : 16, HKV = KIND ? 8 : 4;
  constexpr int LDQ = HQ * DQK, LDK = HKV * DQK, KROW = DQK * 2, VROW = 128;
  constexpr int KS_BYTES = 64 * KROW, STAGE = KS_BYTES + DV * VROW;
  constexpr int NKC = 64 * (DQK / 8) / 512, NVC = DV * 8 / 512, NKS = DQK / 32, NDT = DV / 16, KCPR = DQK / 8;
  static_assert(3 * STAGE <= SMEM_BYTES, "attn lds");
  constexpr float LOG2E = 1.4426950408889634f;
  const bf16_t* Qb = WSP<bf16_t>(p, KIND ? ML_QB : GQ_QB); const bf16_t* Kb = WSP<bf16_t>(p, KIND ? ML_KB : GQ_KB);
  const bf16_t* Vt = WSP<bf16_t>(p, KIND ? ML_VT : GQ_VT); const bf16_t* G = WSP<bf16_t>(p, KIND ? ML_G : GQ_G);
  bf16_t* O = WSP<bf16_t>(p, OFF_HB);
  const int tid = TIDX, lane = tid & 63, w = __builtin_amdgcn_readfirstlane(tid >> 6), r16 = lane & 15, kq = lane >> 4;
  const int fsw = (r16 >> 1) & 7;
  const int n_lat = KIND ? NB * 8 * (S / 256) : NB * 4 * (S / 64);
  const int n_ctx = with_ctx ? (KIND ? NB * 8 : NB * 4 * 4) : 0;
  for (int item = vblock(); item < n_lat + n_ctx; item += gridDim.x) {
    const bool isc = item >= n_lat;
    int b, kvh, q0, nw = 0, wrow0 = 0, qs = 0, lo = 0;
    if (!isc) {
      if (KIND) { const int qb = item % 32; kvh = (item / 32) % 8; b = item / 256; q0 = b * S + qb * 256; nw = 128; wrow0 = b * S; }
      else { const int qb = item % 128; kvh = (item / 128) % 4; b = item / 512; qs = qb * 64; lo = qs - 128 < 0 ? 0 : qs - 128; const int hi = qs + 192 > S ? S : qs + 192; nw = (hi - lo) / 64; wrow0 = b * S + lo; q0 = b * S + qs; }
    } else {
      const int j = item - n_lat;
      if (KIND) { kvh = j % 8; b = j / 8; q0 = NLAT + b * L; }
      else { const int qb = j % 4; kvh = (j / 4) % 4; b = j / 16; q0 = NLAT + b * L + qb * 64; }
    }
    const int ntl = nw + 4, crow0 = NLAT + b * L;
    const int head = KIND ? kvh : kvh * 4 + (w & 3);
    const int qrow0 = (KIND ? q0 + w * 32 : q0 + (w >> 2) * 32) + r16;
    const int qp0 = qs + (w >> 2) * 32 + r16;
    bf16x8 qf[2][NKS];
#pragma unroll
    for (int qt = 0; qt < 2; ++qt)
#pragma unroll
      for (int ks = 0; ks < NKS; ++ks) qf[qt][ks] = *(const bf16x8*)(Qb + (size_t)(qrow0 + 16 * qt) * LDQ + head * DQK + ks * 32 + kq * 8);
#pragma unroll
    for (int qt = 0; qt < 2; ++qt)
#pragma unroll
      for (int ks = 0; ks < NKS; ++ks) asm volatile("" :: "v"(qf[qt][ks]));
    float m[2], l[2];
    f32x4 o[2][NDT];
#pragma unroll
    for (int qt = 0; qt < 2; ++qt) {
      m[qt] = KIND ? -1e30f : sink[head] * LOG2E; l[qt] = KIND ? 0.f : 1.f;
#pragma unroll
      for (int i = 0; i < NDT; ++i)
#pragma unroll
        for (int e = 0; e < 4; ++e) o[qt][i][e] = 0.f;
    }
    unsigned gk[NKC], gv[NVC];
#pragma unroll
    for (int i = 0; i < NKC; ++i) { const int q = (w + 8 * i) * 64 + lane, row = q / KCPR, cp = q % KCPR; gk[i] = (unsigned)(row * LDK + kvh * DQK + ((cp ^ ((row >> 1) & 7)) << 3)); }
#pragma unroll
    for (int i = 0; i < NVC; ++i) { const int row = 8 * (w + 8 * i) + (lane >> 3), cp = lane & 7;
      const int prow = (row & ~31) | (((row >> 2) & 3) << 3) | (((row >> 4) & 1) << 2) | (row & 3);
      gv[i] = (unsigned)((kvh * DV + prow) * NT + ((cp ^ ((row >> 1) & 7)) << 3)); }
#define A_ISSUE(t, buf) do { const int key0_ = (t) < nw ? wrow0 + 64 * (t) : crow0 + 64 * ((t) - nw); char* st_ = smem + (buf) * STAGE; \
      const bf16_t* kb_ = Kb + (size_t)key0_ * LDK; const bf16_t* vb_ = Vt + key0_; \
      _Pragma("unroll") for (int i = 0; i < NKC; ++i) GLDS16(kb_ + gk[i], st_ + (w + 8 * i) * 1024); \
      _Pragma("unroll") for (int i = 0; i < NVC; ++i) GLDS16(vb_ + gv[i], st_ + KS_BYTES + (w + 8 * i) * 1024); } while (0)
    A_ISSUE(0, 0); A_ISSUE(1, 1);
    int buf = 0;
#pragma clang loop unroll(disable)
    for (int t = 0; t < ntl; ++t) {
      if (t + 1 < ntl) { if (NKC + NVC == 5) WAIT_VM(5); else WAIT_VM(2); } else WAIT_VM(0);
      RAW_BARRIER();
      if (t + 2 < ntl) { const int nb = buf >= 1 ? buf - 1 : 2; A_ISSUE(t + 2, nb); }
      const char* Ks = smem + buf * STAGE + r16 * KROW; const char* Vs = smem + buf * STAGE + KS_BYTES + r16 * VROW;
      buf = buf == 2 ? 0 : buf + 1;
      f32x4 s[2][4];
#pragma unroll
      for (int qt = 0; qt < 2; ++qt)
#pragma unroll
        for (int kt = 0; kt < 4; ++kt)
#pragma unroll
          for (int e = 0; e < 4; ++e) s[qt][kt][e] = 0.f;
      {
        bf16x8 a[4], an[4];
#pragma unroll
        for (int kt = 0; kt < 4; ++kt) a[kt] = *(const bf16x8*)(Ks + kt * 16 * KROW + ((kq ^ fsw) << 4));
#pragma unroll
        for (int ks = 0; ks < NKS; ++ks) {
          if (ks + 1 < NKS) {
            const int kco = ((4 * (ks + 1) + kq) ^ fsw) << 4;
#pragma unroll
            for (int kt = 0; kt < 4; ++kt) an[kt] = *(const bf16x8*)(Ks + kt * 16 * KROW + kco);
          }
#pragma unroll
          for (int kt = 0; kt < 4; ++kt)
#pragma unroll
            for (int qt = 0; qt < 2; ++qt) s[qt][kt] = MFMA16(a[kt], qf[qt][ks], s[qt][kt]);
#pragma unroll
          for (int kt = 0; kt < 4; ++kt) a[kt] = an[kt];
        }
      }
      bf16x8 pf[2][2];
      const int wq_lo = qs + (w >> 2) * 32, tk_lo = lo + 64 * t;
      const bool need_mask = (tk_lo + 63 - wq_lo > 128) || (wq_lo + 31 - tk_lo > 128);
#pragma unroll
      for (int qt = 0; qt < 2; ++qt) {
        if (KIND == 0 && !isc && t < nw && need_mask) {
          const int kb0 = lo + 64 * t + 4 * kq, qp = qp0 + 16 * qt;
#pragma unroll
          for (int kt = 0; kt < 4; ++kt)
#pragma unroll
            for (int e = 0; e < 4; ++e) { int d0 = kb0 + 16 * kt + e - qp; d0 = d0 < 0 ? -d0 : d0; if (d0 > 128) s[qt][kt][e] = -1e30f; }
        }
        float tmax = s[qt][0][0];
#pragma unroll
        for (int kt = 0; kt < 4; ++kt)
#pragma unroll
          for (int e = 0; e < 4; ++e) tmax = fmaxf(tmax, s[qt][kt][e]);
        tmax = fmaxf(tmax, __shfl_xor(tmax, 16)); tmax = fmaxf(tmax, __shfl_xor(tmax, 32));
        const float mn = fmaxf(m[qt], tmax);
        const bool resc = __any(mn > m[qt]);
        const float alpha = resc ? __builtin_amdgcn_exp2f(m[qt] - mn) : 1.f;
        m[qt] = mn;
        const f32x4 mn4 = {mn, mn, mn, mn};
        f32x4 rs4 = {0.f, 0.f, 0.f, 0.f};
#pragma unroll
        for (int kt = 0; kt < 4; ++kt) {
          const f32x4 d = s[qt][kt] - mn4;
#pragma unroll
          for (int e = 0; e < 4; ++e) s[qt][kt][e] = __builtin_amdgcn_exp2f(d[e]);
          rs4 += s[qt][kt];
        }
        float rsum = (rs4[0] + rs4[1]) + (rs4[2] + rs4[3]);
        rsum += __shfl_xor(rsum, 16); rsum += __shfl_xor(rsum, 32);
        l[qt] = l[qt] * alpha + rsum;
        if (resc) {
#pragma unroll
          for (int i = 0; i < NDT; ++i)
#pragma unroll
            for (int e = 0; e < 4; ++e) o[qt][i][e] *= alpha;
        }
#pragma unroll
        for (int st = 0; st < 2; ++st) {
          u32x4 u = {pack2(s[qt][2 * st][0], s[qt][2 * st][1]), pack2(s[qt][2 * st][2], s[qt][2 * st][3]), pack2(s[qt][2 * st + 1][0], s[qt][2 * st + 1][1]), pack2(s[qt][2 * st + 1][2], s[qt][2 * st + 1][3])};
          pf[qt][st] = __builtin_bit_cast(bf16x8, u);
        }
      }
      {
        bf16x8 vc[2], vn[2];
#pragma unroll
        for (int st = 0; st < 2; ++st) vc[st] = *(const bf16x8*)(Vs + (((4 * st + kq) ^ fsw) << 4));
#pragma unroll
        for (int dt = 0; dt < NDT; ++dt) {
          if (dt + 1 < NDT) {
#pragma unroll
            for (int st = 0; st < 2; ++st) vn[st] = *(const bf16x8*)(Vs + (dt + 1) * 16 * VROW + (((4 * st + kq) ^ fsw) << 4));
          }
#pragma unroll
          for (int st = 0; st < 2; ++st)
#pragma unroll
            for (int qt = 0; qt < 2; ++qt) o[qt][dt] = MFMA16(vc[st], pf[qt][st], o[qt][dt]);
#pragma unroll
          for (int st = 0; st < 2; ++st) vc[st] = vn[st];
        }
      }
    }
    RAW_BARRIER();
#pragma unroll
    for (int qt = 0; qt < 2; ++qt) {
      const float inv = 1.f / l[qt];
#pragma unroll
      for (int dp = 0; dp < NDT / 2; ++dp) {
        const size_t oi = (size_t)(qrow0 + 16 * qt) * 1024 + head * DV + dp * 32 + 8 * kq;
        const uint4 g8 = *(const uint4*)(G + oi);
        float gf[8]; unpack8(g8, gf);
        u32x4_t wv = {pack2rne(o[qt][2 * dp][0] * inv * gf[0], o[qt][2 * dp][1] * inv * gf[1]), pack2rne(o[qt][2 * dp][2] * inv * gf[2], o[qt][2 * dp][3] * inv * gf[3]),
                      pack2rne(o[qt][2 * dp + 1][0] * inv * gf[4], o[qt][2 * dp + 1][1] * inv * gf[5]), pack2rne(o[qt][2 * dp + 1][2] * inv * gf[6], o[qt][2 * dp + 1][3] * inv * gf[7])};
        *(u32x4_t*)(O + oi) = wv;
      }
    }
  }
}

constexpr int LKR = 272;
DI void phase_lstm_scan(const P& p, char* smem) {
  const bf16_t* QK = WSP<bf16_t>(p, OFF_HB); const bf16_t* Vt = WSP<bf16_t>(p, LS_VT);
  const float *EE = WSP<float>(p, LS_EE), *TOT = WSP<float>(p, LS_TOT), *MLOC = WSP<float>(p, LS_MLOC);
  float *MST = WSP<float>(p, LS_MST), *NST = WSP<float>(p, LS_NST); bf16_t* CST = WSP<bf16_t>(p, LS_CST);
  const int tid = TIDX, lane = tid & 63, w = tid >> 6, r = lane & 31, h = lane >> 5;
  const int srow = tid >> 4, scc = tid & 15;
  for (int item = blockIdx.x; item < 256; item += gridDim.x) {
    const int vs = item & 7, dir = (item >> 3) & 1, hd = (item >> 4) & 3, b = item >> 6, bhd = (b * 4 + hd) * 2 + dir;
    f32x16 C;
#pragma unroll
    for (int e = 0; e < 16; ++e) C[e] = 0.f;
    float nst = 0.f, m = -1e30f;
    u32x4 k0, k1, k2, k3; float e0, e1, e2, e3;
#define S_LOAD(c) do { const int base_ = chunk_base(b, dir, (c)); const bf16_t* kp_ = QK + (size_t)(base_ + srow) * 1024 + 512 + hd * 128 + scc * 8; const float* ep_ = EE + ((size_t)dir * 4 + hd) * NT + base_ + srow; \
      k0 = *(const u32x4*)(kp_); k1 = *(const u32x4*)(kp_ + 32 * 1024); k2 = *(const u32x4*)(kp_ + 64 * 1024); k3 = *(const u32x4*)(kp_ + 96 * 1024); e0 = ep_[0]; e1 = ep_[32]; e2 = ep_[64]; e3 = ep_[96]; } while (0)
#define S_SCALE(kv, sc) ({ u32x4 o_; _Pragma("unroll") for (int q_ = 0; q_ < 4; ++q_) { const unsigned u_ = (kv)[q_]; o_[q_] = pack2(__uint_as_float(u_ << 16) * (sc), __uint_as_float(u_ & 0xffff0000u) * (sc)); } o_; })
    S_LOAD(0);
    for (int c = 0; c < NCH; ++c) {
      const int it = bhd * NCH + c, base = chunk_base(b, dir, c);
      const float tot = TOT[it], ml = MLOC[it], mn = fmaxf(tot + m, ml), a = __expf(tot + m - mn), bb = __expf(ml - mn);
      char* Ks = smem + (c & 1) * (128 * LKR);
      { char* d_ = Ks + srow * LKR + scc * 16;
        *(u32x4*)(d_) = S_SCALE(k0, bb * e0); *(u32x4*)(d_ + 32 * LKR) = S_SCALE(k1, bb * e1); *(u32x4*)(d_ + 64 * LKR) = S_SCALE(k2, bb * e2); *(u32x4*)(d_ + 96 * LKR) = S_SCALE(k3, bb * e3); }
      bf16x8 vf[8];
      if (w < 4) {
        const bf16_t* vp = Vt + (size_t)(hd * 256 + vs * 32 + r) * NT + base + 8 * h;
#pragma unroll
        for (int g = 0; g < 8; ++g) vf[g] = *(const bf16x8*)(vp + 16 * g);
      }
      __syncthreads();
      if (c + 1 < NCH) S_LOAD(c + 1);
      if (w < 4) {
        bf16_t* cp = CST + ((size_t)it * 256 + vs * 32 + r) * 128 + 32 * w + 4 * h;
#pragma unroll
        for (int g = 0; g < 4; ++g) { ushort4 o; o.x = f2bf(C[4 * g]); o.y = f2bf(C[4 * g + 1]); o.z = f2bf(C[4 * g + 2]); o.w = f2bf(C[4 * g + 3]); *(ushort4*)(cp + 8 * g) = o; }
#pragma unroll
        for (int e = 0; e < 16; ++e) C[e] *= a;
#pragma unroll
        for (int g = 0; g < 8; ++g) {
          bf16x8 kf;
#pragma unroll
          for (int j = 0; j < 8; ++j) { const int tok = 16 * g + 8 * (j >> 2) + 4 * h + (j & 3); kf[j] = *(const short*)(Ks + tok * LKR + (32 * w + r) * 2); }
          C = MFMA(kf, vf[g], C);
        }
      } else if (w < 6) {
        const int k = tid - 256;
        if (vs == 0) NST[(size_t)it * 128 + k] = nst;
        float sum = 0.f;
#pragma unroll 8
        for (int t = 0; t < 128; ++t) sum += bf2f(*(const bf16_t*)(Ks + t * LKR + k * 2));
        nst = a * nst + sum;
      }
      if (vs == 0 && tid == 0) MST[it] = m;
      m = mn;
    }
    __syncthreads();
  }
}

DI void phase_lstm_out(const P& p, char* smem) {
  const bf16_t* QK = WSP<bf16_t>(p, OFF_HB); const bf16_t* Vt = WSP<bf16_t>(p, LS_VT);
  const float *CUM = WSP<float>(p, LS_CUM), *PM = WSP<float>(p, LS_PM), *BV = WSP<float>(p, LS_BV);
  const float *MST = WSP<float>(p, LS_MST), *NST = WSP<float>(p, LS_NST); const bf16_t* CST = WSP<bf16_t>(p, LS_CST);
  bf16_t* OB = WSP<bf16_t>(p, LS_OB); const bf16_t* G = WSP<bf16_t>(p, LS_G);
  char* Ks = smem; char* Vs = smem + 128 * LKR;
  float* bvs = (float*)(smem + 384 * LKR); float* nss = bvs + 256; float* red = nss + 256;
  static_assert(384 * LKR + 3 * 1024 <= SMEM_BYTES, "lstm out lds");
  const int tid = TIDX, lane = tid & 63, w = tid >> 6, r = lane & 31, h = lane >> 5;
  const int tt = w & 3, vh = w >> 2;
  for (int item = blockIdx.x; item < NB * 4 * NCH; item += gridDim.x) {
    const int mb = item % NCH, hd = (item / NCH) & 3, b = item / (NCH * 4);
    const int base = mb < 2 ? NLAT + b * L + mb * 128 : b * S + (mb - 2) * 128;
    {
      const int srow = tid >> 4, scc = tid & 15;
      u32x4 kst[4], vst[8];
#pragma unroll
      for (int i = 0; i < 4; ++i) kst[i] = *(const u32x4*)(QK + (size_t)(base + srow + 32 * i) * 1024 + 512 + hd * 128 + scc * 8);
#pragma unroll
      for (int i = 0; i < 8; ++i) vst[i] = *(const u32x4*)(Vt + (size_t)(hd * 256 + srow + 32 * i) * NT + base + scc * 8);
#pragma unroll
      for (int i = 0; i < 4; ++i) *(u32x4*)(Ks + (srow + 32 * i) * LKR + scc * 16) = kst[i];
#pragma unroll
      for (int i = 0; i < 8; ++i) *(u32x4*)(Vs + (srow + 32 * i) * LKR + scc * 16) = vst[i];
    }
    int its[2];
#pragma unroll
    for (int dir = 0; dir < 2; ++dir) { const int c = mb < 2 ? (dir ? 1 - mb : mb) : 2 + (dir ? 63 - (mb - 2) : mb - 2); its[dir] = ((b * 4 + hd) * 2 + dir) * NCH + c; }
    if (tid < 256) {
      const int dir = tid >> 7, i = tid & 127; bvs[tid] = BV[((size_t)dir * 4 + hd) * NT + base + i];
      const float* ns = NST + (size_t)(dir ? its[1] : its[0]) * 128; const bf16_t* qp = QK + (size_t)(base + i) * 1024 + hd * 128; float s_ = 0.f;
      for (int k = 0; k < 128; k += 8) { float qv[8]; unpack8(*(const uint4*)(qp + k), qv); const float4 n0 = *(const float4*)(ns + k), n1 = *(const float4*)(ns + k + 4);
        s_ += qv[0] * n0.x + qv[1] * n0.y + qv[2] * n0.z + qv[3] * n0.w + qv[4] * n1.x + qv[5] * n1.y + qv[6] * n1.z + qv[7] * n1.w; }
      nss[tid] = s_;
    }
    const int trow = base + tt * 32 + r;
    float mstv[2], pmv[2], cumv[2];
#pragma unroll
    for (int dir = 0; dir < 2; ++dir) { const size_t po = ((size_t)dir * 4 + hd) * NT + trow; mstv[dir] = MST[its[dir]]; pmv[dir] = PM[po]; cumv[dir] = CUM[po]; }
    bf16x8 qf[8];
#pragma unroll
    for (int ks = 0; ks < 8; ++ks) qf[ks] = *(const bf16x8*)(QK + (size_t)trow * 1024 + hd * 128 + ks * 16 + h * 8);
    __syncthreads();
    f32x16 hs[4];
#pragma unroll
    for (int i = 0; i < 4; ++i)
#pragma unroll
      for (int e = 0; e < 16; ++e) hs[i][e] = 0.f;
#pragma unroll 1
    for (int dir = 0; dir < 2; ++dir) {
      const int itd = dir ? its[1] : its[0];
      const float mst = dir ? mstv[1] : mstv[0], pmx = dir ? pmv[1] : pmv[0], cmx = dir ? cumv[1] : cumv[0];
      const float mx = fmaxf(mst, pmx), at = __expf(mst - mx), fl = __expf(-cmx - mx);
      const float nq = nss[dir * 128 + tt * 32 + r];
      float den = at * nq;
      const int st_lo = dir ? tt : 0, st_hi = dir ? 3 : tt;
      for (int st = st_lo; st <= st_hi; ++st) {
        f32x16 sc;
#pragma unroll
        for (int e = 0; e < 16; ++e) sc[e] = 0.f;
#pragma unroll
        for (int ks = 0; ks < 8; ++ks) { const bf16x8 kf = *(const bf16x8*)(Ks + (st * 32 + r) * LKR + ks * 32 + h * 16); sc = MFMA(kf, qf[ks], sc); }
        float ps = 0.f;
#pragma unroll
        for (int e = 0; e < 16; ++e) {
          const int sl = (e & 3) + 8 * (e >> 2) + 4 * h;
          float wgt = __expf(bvs[dir * 128 + st * 32 + sl] - mx);
          if (st == tt && (dir ? sl < r : sl > r)) wgt = 0.f;
          ps += sc[e] * wgt;
        }
        den += ps + __shfl_xor(ps, 32);
      }
      const float dinv = 1.f / fmaxf(fabsf(den), fl);
      {
        const float sq = at * dinv;
        const bf16_t* cp = CST + ((size_t)itd * 256 + vh * 128 + r) * 128 + 8 * h;
#pragma unroll
        for (int vt = 0; vt < 4; ++vt) {
          bf16x8 cf[8];
#pragma unroll
          for (int ks = 0; ks < 8; ++ks) cf[ks] = *(const bf16x8*)(cp + (size_t)vt * 32 * 128 + ks * 16);
          f32x16 ta;
#pragma unroll
          for (int e = 0; e < 16; ++e) ta[e] = 0.f;
#pragma unroll
          for (int ks = 0; ks < 8; ++ks) ta = MFMA(cf[ks], qf[ks], ta);
#pragma unroll
          for (int e = 0; e < 16; ++e) hs[vt][e] += sq * ta[e];
        }
      }
      for (int st = st_lo; st <= st_hi; ++st) {
        f32x16 sc;
#pragma unroll
        for (int e = 0; e < 16; ++e) sc[e] = 0.f;
#pragma unroll
        for (int ks = 0; ks < 8; ++ks) { const bf16x8 kf = *(const bf16x8*)(Ks + (st * 32 + r) * LKR + ks * 32 + h * 16); sc = MFMA(kf, qf[ks], sc); }
#pragma unroll
        for (int e = 0; e < 16; ++e) {
          const int sl = (e & 3) + 8 * (e >> 2) + 4 * h;
          float wgt = __expf(bvs[dir * 128 + st * 32 + sl] - mx) * dinv;
          if (st == tt && (dir ? sl < r : sl > r)) wgt = 0.f;
          sc[e] *= wgt;
        }
        bf16x8 pf[2];
#pragma unroll
        for (int s2 = 0; s2 < 2; ++s2) { u32x4 u = {pack2(sc[8 * s2], sc[8 * s2 + 1]), pack2(sc[8 * s2 + 2], sc[8 * s2 + 3]), pack2(sc[8 * s2 + 4], sc[8 * s2 + 5]), pack2(sc[8 * s2 + 6], sc[8 * s2 + 7])}; pf[s2] = __builtin_bit_cast(bf16x8, u); }
#pragma unroll
        for (int vt = 0; vt < 4; ++vt)
#pragma unroll
          for (int s2 = 0; s2 < 2; ++s2) { const bf16x8 vf = *(const bf16x8*)(Vs + (vh * 128 + vt * 32 + r) * LKR + (st * 32 + s2 * 16) * 2 + h * 16); hs[vt] = MFMA(vf, pf[s2], hs[vt]); }
      }
    }
    const size_t ob0 = (size_t)trow * 1024 + hd * 256 + vh * 128 + 4 * h;
    ushort4 obv[16];
#pragma unroll
    for (int q = 0; q < 16; ++q) obv[q] = *(const ushort4*)(OB + ob0 + (q >> 2) * 32 + (q & 3) * 8);
    float ss = 0.f;
#pragma unroll
    for (int vt = 0; vt < 4; ++vt)
#pragma unroll
      for (int g = 0; g < 4; ++g) {
        const ushort4 ov = obv[vt * 4 + g];
        hs[vt][4 * g] *= bf2f(ov.x); hs[vt][4 * g + 1] *= bf2f(ov.y); hs[vt][4 * g + 2] *= bf2f(ov.z); hs[vt][4 * g + 3] *= bf2f(ov.w);
        ss += hs[vt][4 * g] * hs[vt][4 * g] + hs[vt][4 * g + 1] * hs[vt][4 * g + 1] + hs[vt][4 * g + 2] * hs[vt][4 * g + 2] + hs[vt][4 * g + 3] * hs[vt][4 * g + 3];
      }
    ss += __shfl_xor(ss, 32);
    if (h == 0) red[vh * 128 + tt * 32 + r] = ss;
    ushort4 gvv[16];
#pragma unroll
    for (int q = 0; q < 16; ++q) gvv[q] = *(const ushort4*)(G + ob0 + (q >> 2) * 32 + (q & 3) * 8);
    __syncthreads();
    const float rs = rsqrtf((red[tt * 32 + r] + red[128 + tt * 32 + r]) * (1.f / 256) + EPS);
    const float* ghp = p.g_head + hd * 256 + vh * 128 + 4 * h;
#pragma unroll
    for (int vt = 0; vt < 4; ++vt) {
      float4 ghv[4];
#pragma unroll
      for (int g = 0; g < 4; ++g) ghv[g] = *(const float4*)(ghp + vt * 32 + g * 8);
#pragma unroll
      for (int g = 0; g < 4; ++g) {
        const ushort4 gv = gvv[vt * 4 + g]; const float4 gh = ghv[g];
        float v[4] = {hs[vt][4 * g] * rs * gh.x * bf2f(gv.x), hs[vt][4 * g + 1] * rs * gh.y * bf2f(gv.y), hs[vt][4 * g + 2] * rs * gh.z * bf2f(gv.z), hs[vt][4 * g + 3] * rs * gh.w * bf2f(gv.w)};
        st4(OB + ob0 + vt * 32 + g * 8, v);
      }
    }
    __syncthreads();
  }
}
__global__ __launch_bounds__(512) void k_lstm_scan(P p) { __shared__ __attribute__((aligned(16))) char smem[SMEM_BYTES]; phase_lstm_scan(p, smem); }
__global__ __launch_bounds__(512) void k_lstm_out(P p) { __shared__ __attribute__((aligned(16))) char smem[SMEM_BYTES]; phase_lstm_out(p, smem); }

#define XB_TMO      128
#define XB_XCNT(j)  (256  + 64 * (j))
#define XB_XSUB(j)  (1280 + 64 * (j))
#define XB_XGEN(j)  (2304 + 64 * (j))
#define XB_TOP      3328
#define XB_TOPGEN   3392
#define XCD_BAR_WORDS 3456
#define XB_SPIN_CAP (1u << 18)
#define LAS __attribute__((address_space(3)))

__device__ __forceinline__ unsigned xb_ld(unsigned* p)              { return __hip_atomic_load(p, __ATOMIC_RELAXED, __HIP_MEMORY_SCOPE_AGENT); }
__device__ __forceinline__ unsigned xb_add(unsigned* p, unsigned v) { return __hip_atomic_fetch_add(p, v, __ATOMIC_RELAXED, __HIP_MEMORY_SCOPE_AGENT); }
__device__ __forceinline__ unsigned xb_xcc_id() { return (unsigned)__builtin_amdgcn_s_getreg((3 << 11) | 20) & 0xFu; }
#define XB_SPIN(cond, bar) do { unsigned _sp = 0; while (cond) { __builtin_amdgcn_s_sleep(1); \
    if ((++_sp & 255u) == 0u) { if (xb_ld(&(bar)[XB_TMO])) break; if (_sp > XB_SPIN_CAP) { atomicAdd(&(bar)[XB_TMO], 1u); break; } } } } while (0)

struct XcdBarrier {
    unsigned* bar; unsigned x;
    volatile LAS unsigned* st;
};

__device__ __forceinline__ XcdBarrier xcd_barrier_post(unsigned* bar, volatile LAS unsigned* st) {
    XcdBarrier b; b.bar = bar; b.x = xb_xcc_id(); b.st = st;
    if (TIDX == 0) (void)xb_add(&bar[XB_XCNT(b.x)], 1u);
    return b;
}
__device__ __forceinline__ void xcd_barrier_complete(unsigned* bar, unsigned x, unsigned& nloc, unsigned& nx) {
    const unsigned G = gridDim.x * gridDim.y * gridDim.z;
    unsigned sum, cnt, mine, sp = 0u;
    for (;;) {
        sum = 0u; cnt = 0u; mine = 0u;
#pragma unroll
        for (unsigned j = 0; j < 16; ++j) { const unsigned c = xb_ld(&bar[XB_XCNT(j)]); sum += c; cnt += (c > 0u) ? 1u : 0u; mine = (j == x) ? c : mine; }
        if (sum == G) break;
        __builtin_amdgcn_s_sleep(1);
        if ((++sp & 255u) == 0u) { if (xb_ld(&bar[XB_TMO])) break; if (sp > XB_SPIN_CAP) { atomicAdd(&bar[XB_TMO], 1u); break; } }
    }
    nloc = mine > 0u ? mine : 1u; nx = cnt > 0u ? cnt : 1u;
}

__device__ __forceinline__ void xcd_barrier(const XcdBarrier& b) {
    asm volatile("s_waitcnt vmcnt(0)" ::: "memory");
    __syncthreads();
    if (TIDX == 0) {
        unsigned* bar = b.bar;
        __builtin_amdgcn_s_waitcnt(0);
        unsigned nloc = b.st[0], nx = b.st[1];
        if (nloc == 0u) { xcd_barrier_complete(bar, b.x, nloc, nx); b.st[0] = nloc; b.st[1] = nx; }
        const unsigned old = xb_add(&bar[XB_XSUB(b.x)], 1u);
        const unsigned gen = old / nloc;
        if (old + 1u == (gen + 1u) * nloc) {
            __builtin_amdgcn_fence(__ATOMIC_RELEASE, "agent");
            asm volatile("s_waitcnt vmcnt(0)" ::: "memory");
            const unsigned og = xb_add(&bar[XB_TOP], 1u);
            const unsigned tg = og / nx;
            if (og + 1u == (tg + 1u) * nx) xb_add(&bar[XB_TOPGEN], 1u);
            else XB_SPIN(xb_ld(&bar[XB_TOPGEN]) == tg, bar);
            __builtin_amdgcn_fence(__ATOMIC_ACQUIRE, "agent");
            xb_add(&bar[XB_XGEN(b.x)], 1u);
            asm volatile("s_waitcnt vmcnt(0)" ::: "memory");
        } else {
            XB_SPIN(xb_ld(&bar[XB_XGEN(b.x)]) == gen, bar);
            __builtin_amdgcn_fence(__ATOMIC_ACQUIRE, "agent");
            asm volatile("s_waitcnt vmcnt(0)" ::: "memory");
        }
    }
    __syncthreads();
}


namespace cg = cooperative_groups;
#ifndef REP_MLA
#define REP_MLA 1
#endif
#ifndef REP_GEMM
#define REP_GEMM 1
#endif
#ifndef REP_GOUT
#define REP_GOUT 1
#endif
#ifndef REP_GSM
#define REP_GSM 1
#endif
#ifndef REP_PRO
#define REP_PRO 1
#endif
#ifndef REP_CONV
#define REP_CONV 1
#endif
#ifndef REP_ROW0
#define REP_ROW0 1
#endif
#ifndef REP_SYNC
#define REP_SYNC 1
#endif
#ifndef REP_GQA
#define REP_GQA 1
#endif
#ifndef REP_LSTM
#define REP_LSTM 1
#endif
#define REPEAT(n) for (int rep_ = 0; rep_ < (n); ++rep_)
__global__ __launch_bounds__(512) void k_mega(P p) {
  __shared__ __attribute__((aligned(16))) char smem[SMEM_BYTES];
  cg::grid_group grid = cg::this_grid();
  __shared__ uint4 xb_words;
  if (TIDX == 0) xb_words = make_uint4(0u, 0u, 0u, 0u);
  __syncthreads();
  const XcdBarrier xb = xcd_barrier_post(WSP<unsigned>(p, OFF_BAR), (volatile LAS unsigned*)&xb_words);
  bf16_t* HB = WSP<bf16_t>(p, OFF_HB);
  REPEAT(REP_PRO) phase_prologue(p, smem); REPEAT(REP_SYNC) grid.sync();
  REPEAT(REP_ROW0) phase_rowwise(p, 0, nullptr); xcd_barrier(xb);
  REPEAT(REP_GEMM) phase_gemm<M_IN_GQA, false>(p, HB, 1024, WINT(p, 0), 1024, 2560, NT, nullptr, smem); xcd_barrier(xb);
  REPEAT(REP_GQA) phase_attn<0>(p, p.sink[0], true, smem); xcd_barrier(xb);
  REPEAT(REP_GOUT) phase_gemm<M_OUT, false>(p, HB, 1024, WOUTT(p, 0), 1024, 1024, NT, WSP<bf16_t>(p, GQ_Y), smem); xcd_barrier(xb);
  phase_rowwise(p, 1, WSP<bf16_t>(p, GQ_Y)); xcd_barrier(xb);
  REPEAT(REP_GEMM) phase_gemm<M_IN_MLA, false>(p, HB, 1024, WINT(p, 1), 1024, 1472, NT, nullptr, smem); xcd_barrier(xb);
  REPEAT(REP_GSM) phase_gemm<M_UQ, true>(p, WSP<bf16_t>(p, ML_QA), 256, WSP<bf16_t>(p, OFF_WUQ), 256, 1536, NT, nullptr, smem);
  REPEAT(REP_GSM) phase_gemm<M_UKV, true>(p, WSP<bf16_t>(p, ML_KVA), 128, WSP<bf16_t>(p, OFF_WUKV), 128, 2048, NT, nullptr, smem); xcd_barrier(xb);
  REPEAT(REP_MLA) phase_attn<1>(p, nullptr, true, smem); xcd_barrier(xb);
  REPEAT(REP_GOUT) phase_gemm<M_OUT, false>(p, HB, 1024, WOUTT(p, 1), 1024, 1024, NT, WSP<bf16_t>(p, ML_Y), smem); xcd_barrier(xb);
  phase_rowwise(p, 2, WSP<bf16_t>(p, ML_Y)); xcd_barrier(xb);
  REPEAT(REP_GEMM) phase_gemm<M_IN_LSTM, false>(p, HB, 1024, WINT(p, 2), 1024, 4112, NT, nullptr, smem); xcd_barrier(xb);
  REPEAT(REP_CONV) { phase_conv(p); phase_prep(p); } xcd_barrier(xb);
  REPEAT(REP_LSTM) phase_lstm_scan(p, smem); xcd_barrier(xb);
  phase_lstm_out(p, smem); xcd_barrier(xb);
  REPEAT(REP_GOUT) phase_gemm<M_OUT, false>(p, WSP<bf16_t>(p, LS_OB), 1024, WOUTT(p, 2), 1024, 1024, NT, WSP<bf16_t>(p, LS_Y), smem); xcd_barrier(xb);
  phase_rowwise(p, 3, WSP<bf16_t>(p, LS_Y)); xcd_barrier(xb);
  REPEAT(REP_GEMM) phase_gemm<M_IN_GQA, false>(p, HB, 1024, WINT(p, 3), 1024, 2560, NT, nullptr, smem); xcd_barrier(xb);
  REPEAT(REP_GQA) phase_attn<0>(p, p.sink[3], false, smem); xcd_barrier(xb);
  REPEAT(REP_GOUT) phase_gemm<M_OUT, false>(p, HB, 1024, WOUTT(p, 3), 1024, 1024, NLAT, WSP<bf16_t>(p, GQ_Y), smem); xcd_barrier(xb);
  phase_rowwise(p, 4, WSP<bf16_t>(p, GQ_Y));
}

template <int MODE, bool ROWSCALE>
__global__ __launch_bounds__(512) void k_gemm(P p, const bf16_t* A, int lda, const bf16_t* Wt, int K, int N, int M, bf16_t* Y) {
  __shared__ __attribute__((aligned(16))) char smem[SMEM_BYTES]; phase_gemm<MODE, ROWSCALE>(p, A, lda, Wt, K, N, M, Y, smem);
}
template <int KIND>
__global__ __launch_bounds__(512) void k_attn(P p, const float* sink, int with_ctx) {
  __shared__ __attribute__((aligned(16))) char smem[SMEM_BYTES]; phase_attn<KIND>(p, sink, with_ctx != 0, smem);
}

__global__ __launch_bounds__(256) void k_prologue(P p) { __shared__ __attribute__((aligned(16))) char smem[64 * 68 * 4]; phase_prologue(p, smem); }
__global__ __launch_bounds__(256) void k_rowwise(P p, int l, const bf16_t* Y) { phase_rowwise(p, l, Y); }
__global__ __launch_bounds__(256) void k_conv(P p) { phase_conv(p); }
__global__ __launch_bounds__(256) void k_prep(P p) { phase_prep(p); }


#ifndef MEGA
#define MEGA 1
#endif
#ifndef FAST_LSTM
#define FAST_LSTM 1
#endif
#ifndef FAST_GEMM
#define FAST_GEMM 1
#endif
#ifndef FAST_ATTN
#define FAST_ATTN 1
#endif
#if FAST_GEMM
#define GEMM_L(MODE, RS) k_gemm<MODE, RS><<<256, 512, 0, stream>>>
#else
#define GEMM_L(MODE, RS) k_gemm_naive<MODE, RS><<<G * 4, 256, 0, stream>>>
#endif
#if FAST_ATTN
#define ATTN0_L(l) k_attn<0><<<256, 512, 0, stream>>>(p, p.sink[l], l == 0 ? 1 : 0)
#define ATTN1_L() k_attn<1><<<256, 512, 0, stream>>>(p, nullptr, 1)
#else
#define ATTN0_L(l) k_attn_naive<0><<<G * 4, 256, 0, stream>>>(p, p.sink[l], 0, Mout)
#define ATTN1_L() k_attn_naive<1><<<G * 4, 256, 0, stream>>>(p, nullptr, 0, NT)
#endif

extern "C" void kernel_launch(void* const* d_in, const int* in_sizes, int n_in, void* d_out, int out_size, void* d_ws, size_t ws_size, hipStream_t stream) {
  if (n_in != 37 || ws_size < WS_NEED) { fprintf(stderr, "kernel_launch: bad n_in %d or ws %zu < %zu\n", n_in, ws_size, (size_t)WS_NEED); return; }
  P p{};
  auto F = [&](int i) { return (const float*)d_in[i]; };
  p.x = F(0); p.c = F(1); p.ctx = F(2); p.cctx = F(3);
  const int base[4] = {4, 11, 21, 30};
  for (int l = 0; l < 4; ++l) { p.w_ada[l] = F(base[l]); p.b_ada[l] = F(base[l] + 1); p.g_pre[l] = F(base[l] + 2); p.g_post[l] = F(base[l] + 3); p.w_in[l] = F(base[l] + 4); p.sink[l] = nullptr; }
  p.sink[0] = F(9); p.w_out[0] = F(10);
  p.g_qa = F(16); p.g_kva = F(17); p.w_uq = F(18); p.w_ukv = F(19); p.w_out[1] = F(20);
  p.conv = F(26); p.b_gate = F(27); p.g_head = F(28); p.w_out[2] = F(29);
  p.sink[3] = F(35); p.w_out[3] = F(36);
  p.out = (float*)d_out; p.ws = (char*)d_ws;
  char* ws = (char*)d_ws;
  bf16_t* HB = (bf16_t*)(ws + OFF_HB);
#if MEGA
  {
    static int grid_blocks = 0;
    if (!grid_blocks) {
      int dev = 0, cus = 0, per_cu = 0;
      (void)hipGetDevice(&dev); (void)hipDeviceGetAttribute(&cus, hipDeviceAttributeMultiprocessorCount, dev);
      (void)hipOccupancyMaxActiveBlocksPerMultiprocessor(&per_cu, k_mega, 512, 0);
      if (per_cu < 1) per_cu = 1;
      grid_blocks = cus * per_cu;
    }
    (void)hipMemsetAsync((char*)d_ws + OFF_BAR, 0, (size_t)XCD_BAR_WORDS * 4, stream);
    void* args[] = {&p};
    hipError_t e = hipLaunchCooperativeKernel((void*)k_mega, dim3(grid_blocks), dim3(512), args, 0, stream);
    if (e != hipSuccess) fprintf(stderr, "cooperative launch failed: %s (grid %d)\n", hipGetErrorString(e), grid_blocks);
    return;
  }
#endif
  const int G = 2048;
  k_prologue<<<1024, 256, 0, stream>>>(p);
  for (int l = 0; l < 4; ++l) {
    const int kind = l == 1 ? 1 : (l == 2 ? 2 : 0);
    bf16_t* Yprev = l == 0 ? nullptr : (bf16_t*)(ws + ((l - 1) == 1 ? ML_Y : (l - 1) == 2 ? LS_Y : GQ_Y));
    k_rowwise<<<G, 256, 0, stream>>>(p, l, Yprev);
    bf16_t* Wi = (bf16_t*)(ws + (l == 0 ? OFF_WIN0 : l == 1 ? OFF_WIN1 : l == 2 ? OFF_WIN2 : OFF_WIN3));
    bf16_t* Wo = (bf16_t*)(ws + OFF_WOUT + (size_t)l * al((size_t)1024 * 1024 * 2));
    bf16_t* Y = (bf16_t*)(ws + (kind == 1 ? ML_Y : kind == 2 ? LS_Y : GQ_Y));
    const int Mout = l == 3 ? NLAT : NT; bf16_t* HBo = HB;
    if (kind == 0) {
      GEMM_L(M_IN_GQA, false)(p, HB, 1024, Wi, 1024, 2560, NT, nullptr);
      ATTN0_L(l);
    } else if (kind == 1) {
      GEMM_L(M_IN_MLA, false)(p, HB, 1024, Wi, 1024, 1472, NT, nullptr);
      GEMM_L(M_UQ, true)(p, (bf16_t*)(ws + ML_QA), 256, (bf16_t*)(ws + OFF_WUQ), 256, 1536, NT, nullptr);
      GEMM_L(M_UKV, true)(p, (bf16_t*)(ws + ML_KVA), 128, (bf16_t*)(ws + OFF_WUKV), 128, 2048, NT, nullptr);
      ATTN1_L();
    } else {
      GEMM_L(M_IN_LSTM, false)(p, HB, 1024, Wi, 1024, 4112, NT, nullptr);
      k_conv<<<G, 256, 0, stream>>>(p);
      k_prep<<<(NITEM + 3) / 4, 256, 0, stream>>>(p);
#if FAST_LSTM
      k_lstm_scan<<<256, 512, 0, stream>>>(p);
      k_lstm_out<<<256, 512, 0, stream>>>(p);
      HBo = (bf16_t*)(ws + LS_OB);
#else
      k_lstm_scan_naive<<<32 * 32768 / 256, 256, 0, stream>>>(p);
      const int shm = (2 * 128 * 129 + 4 * 256) * 4;
      static int attr_done = 0;
      if (!attr_done) { hipFuncSetAttribute((const void*)k_lstm_out_naive, hipFuncAttributeMaxDynamicSharedMemorySize, shm); attr_done = 1; }
      k_lstm_out_naive<<<NB * 4 * NCH, 256, shm, stream>>>(p);
      k_lstm_finish_naive<<<G, 256, 0, stream>>>(p);
#endif
    }
    GEMM_L(M_OUT, false)(p, HBo, 1024, Wo, 1024, 1024, Mout, Y);
  }
  k_rowwise<<<G, 256, 0, stream>>>(p, 4, (bf16_t*)(ws + GQ_Y));
}
```

```cpp
#include <hip/hip_runtime.h>
#include <hip/hip_bf16.h>
#include <hip/hip_cooperative_groups.h>
#include <stdint.h>
#include <cstdio>

typedef unsigned short bf16_t;
#define DI __device__ __forceinline__

constexpr int D = 1024, NB = 4, S = 8192, L = 256;
constexpr int NLAT = NB * S, NCTX = NB * L, NT = NLAT + NCTX;
constexpr float EPS = 1e-6f;
constexpr int NCH = 66;

DI int opaque_tid() { int t = threadIdx.x; asm volatile("" : "+v"(t)); return t; }
#define TIDX opaque_tid()
DI int vblock() { const int g = gridDim.x; return (g & 7) ? (int)blockIdx.x : (int)(blockIdx.x & 7) * (g >> 3) + (int)(blockIdx.x >> 3); }
DI float bf2f(bf16_t b) { return __uint_as_float(((unsigned)b) << 16); }
DI bf16_t f2bf(float x) { unsigned u = __float_as_uint(x); u += 0x7fffu + ((u >> 16) & 1u); return (bf16_t)(u >> 16); }
DI float silu_f(float x) { return x / (1.f + __expf(-x)); }
DI float sigmoid_f(float x) { return 1.f / (1.f + __expf(-x)); }
DI int vpos(int row) { return (row & ~12) | ((row & 4) << 1) | ((row & 8) >> 1); }
DI int vpos32(int row) { return (row & ~31) | (((row >> 2) & 3) << 3) | (((row >> 4) & 1) << 2) | (row & 3); }
DI float wave_sum(float v) { for (int o = 32; o > 0; o >>= 1) v += __shfl_xor(v, o); return v; }
DI float wave_max(float v) { for (int o = 32; o > 0; o >>= 1) v = fmaxf(v, __shfl_xor(v, o)); return v; }

constexpr size_t al(size_t x) { return (x + 255) / 256 * 256; }
constexpr int NIN[4] = {2560, 1472, 4112, 2560};
constexpr size_t OFF_WIN0 = 0;
constexpr size_t OFF_WIN1 = OFF_WIN0 + al((size_t)2560 * 1024 * 2);
constexpr size_t OFF_WIN2 = OFF_WIN1 + al((size_t)1472 * 1024 * 2);
constexpr size_t OFF_WIN3 = OFF_WIN2 + al((size_t)4112 * 1024 * 2);
constexpr size_t OFF_WOUT = OFF_WIN3 + al((size_t)2560 * 1024 * 2);
constexpr size_t OFF_WUQ = OFF_WOUT + 4 * al((size_t)1024 * 1024 * 2);
constexpr size_t OFF_WUKV = OFF_WUQ + al((size_t)1536 * 256 * 2);
constexpr size_t OFF_MOD = OFF_WUKV + al((size_t)2048 * 128 * 2);
constexpr size_t OFF_ROPE = OFF_MOD + al((size_t)4 * 5 * 3072 * 4);
constexpr size_t OFF_XC = OFF_ROPE + al((size_t)S * 32 * 8);
constexpr size_t OFF_BAR = OFF_XC + al((size_t)NCTX * D * 4);
constexpr size_t OFF_HB = OFF_BAR + al((size_t)4096 * 4);
constexpr size_t OFF_BIG = OFF_HB + al((size_t)NT * D * 2);
constexpr size_t SZ_T1K = al((size_t)NT * 1024 * 2);
constexpr size_t GQ_QB = OFF_BIG;
constexpr size_t GQ_KB = GQ_QB + SZ_T1K;
constexpr size_t GQ_VT = GQ_KB + al((size_t)NT * 256 * 2);
constexpr size_t GQ_G = GQ_VT + al((size_t)NT * 256 * 2);
constexpr size_t GQ_Y = GQ_G + SZ_T1K;
constexpr size_t GQ_END = GQ_Y + al((size_t)NT * 1024 * 4);
constexpr size_t ML_QB = OFF_BIG;
constexpr size_t ML_KB = ML_QB + al((size_t)NT * 1536 * 2);
constexpr size_t ML_Y = OFF_BIG;
constexpr size_t ML_VT = ML_KB + al((size_t)NT * 1536 * 2);
constexpr size_t ML_G = ML_VT + SZ_T1K;
constexpr size_t ML_QA = ML_G + SZ_T1K;
constexpr size_t ML_KVA = ML_QA + al((size_t)NT * 256 * 2);
constexpr size_t ML_END = ML_KVA + al((size_t)NT * 128 * 2);
constexpr size_t LS_QKRAW = OFF_BIG;
constexpr size_t LS_VT = LS_QKRAW + SZ_T1K;
constexpr size_t LS_OB = LS_VT + SZ_T1K;
constexpr size_t LS_G = LS_OB + SZ_T1K;
constexpr size_t LS_GATES = LS_G + SZ_T1K;
constexpr size_t SZ_PT = al((size_t)2 * 4 * NT * 4);
constexpr size_t LS_CUM = LS_GATES + al((size_t)NT * 16 * 4);
constexpr size_t LS_PM = LS_CUM + SZ_PT;
constexpr size_t LS_BV = LS_PM + SZ_PT;
constexpr size_t LS_EE = LS_BV + SZ_PT;
constexpr int NITEM = NB * 4 * 2 * NCH;
constexpr size_t LS_TOT = LS_EE + SZ_PT;
constexpr size_t LS_MLOC = LS_TOT + al((size_t)NITEM * 4);
constexpr size_t LS_MST = LS_MLOC + al((size_t)NITEM * 4);
constexpr size_t LS_NST = LS_MST + al((size_t)NITEM * 4);
constexpr size_t LS_CST = LS_NST + al((size_t)NITEM * 128 * 4);
constexpr size_t LS_Y = LS_CST;
constexpr size_t LS_END = LS_CST + al((size_t)NITEM * 256 * 128 * 2);
constexpr size_t WS_NEED = (GQ_END > ML_END ? (GQ_END > LS_END ? GQ_END : LS_END) : (ML_END > LS_END ? ML_END : LS_END));
static_assert(WS_NEED <= (size_t)536870912, "workspace over budget");
static_assert((size_t)NT * 1024 * 4 <= (size_t)NITEM * 256 * 128 * 2, "Y alias");

struct P {
  const float *x, *c, *ctx, *cctx;
  const float *w_ada[4], *b_ada[4], *g_pre[4], *g_post[4], *w_in[4], *w_out[4], *sink[4];
  const float *g_qa, *g_kva, *w_uq, *w_ukv, *conv, *b_gate, *g_head;
  float* out;
  char* ws;
};
DI bf16_t* WINT(const P& p, int l) { return (bf16_t*)(p.ws + (l == 0 ? OFF_WIN0 : l == 1 ? OFF_WIN1 : l == 2 ? OFF_WIN2 : OFF_WIN3)); }
DI bf16_t* WOUTT(const P& p, int l) { return (bf16_t*)(p.ws + OFF_WOUT + (size_t)l * al((size_t)1024 * 1024 * 2)); }
DI float* MODV(const P& p, int l, int v) { return (float*)(p.ws + OFF_MOD) + ((size_t)l * 5 + v) * 3072; }
template <typename T> DI T* WSP(const P& p, size_t off) { return (T*)(p.ws + off); }

DI void transpose_tile(const float* __restrict__ src, bf16_t* __restrict__ dst, const float* __restrict__ scale, int K, int N, int tile, float (*t)[68]) {
  const int tilesN = (N + 63) / 64, tn = tile % tilesN, tk = tile / tilesN, tid = TIDX;
  for (int c = tid; c < 1024; c += blockDim.x) {
    const int kk = c >> 4, n4 = (c & 15) * 4, k = tk * 64 + kk, n = tn * 64 + n4;
    float4 v = make_float4(0.f, 0.f, 0.f, 0.f);
    if (n < N) v = *(const float4*)(src + (size_t)k * N + n);
    if (scale) { const float s = scale[k]; v.x *= s; v.y *= s; v.z *= s; v.w *= s; }
    *(float4*)&t[kk][n4] = v;
  }
  __syncthreads();
  for (int d = tid; d < 512; d += blockDim.x) {
    const int nn = d & 63, k8 = (d >> 6) * 8, n = tn * 64 + nn;
    if (n < N) {
      unsigned w[4];
#pragma unroll
      for (int q = 0; q < 4; ++q) w[q] = (unsigned)f2bf(t[k8 + 2 * q][nn]) | ((unsigned)f2bf(t[k8 + 2 * q + 1][nn]) << 16);
      *(uint4*)(dst + (size_t)n * K + tk * 64 + k8) = make_uint4(w[0], w[1], w[2], w[3]);
    }
  }
  __syncthreads();
}
DI int ntiles_tr(int K, int N) { return (K / 64) * ((N + 63) / 64); }

DI void phase_prologue(const P& p, char* smem) {
  float (*t)[68] = (float (*)[68])smem;
  for (int j = 0; j < 10; ++j) {
    const float* src; bf16_t* dst; const float* sc = nullptr; int K, N;
    if (j < 4) { src = p.w_in[j]; dst = WINT(p, j); K = 1024; N = NIN[j]; }
    else if (j < 8) { src = p.w_out[j - 4]; dst = WOUTT(p, j - 4); K = 1024; N = 1024; }
    else if (j == 8) { src = p.w_uq; dst = WSP<bf16_t>(p, OFF_WUQ); sc = p.g_qa; K = 256; N = 1536; }
    else { src = p.w_ukv; dst = WSP<bf16_t>(p, OFF_WUKV); sc = p.g_kva; K = 128; N = 2048; }
    const int nt = ntiles_tr(K, N);
    for (int tile = blockIdx.x; tile < nt; tile += gridDim.x) transpose_tile(src, dst, sc, K, N, tile, t);
  }
  {
    float* red = (float*)smem;
    for (int tile = blockIdx.x; tile < 4 * 48; tile += gridDim.x) {
      const int l = tile / 48, cg = tile % 48, col = cg * 64 + (TIDX & 63), kq = TIDX >> 6;
      float acc[5] = {0, 0, 0, 0, 0};
      const float* w = p.w_ada[l];
      if (kq < 4) for (int k = kq * 256; k < kq * 256 + 256; ++k) {
        const float wv = w[(size_t)k * 3072 + col];
#pragma unroll
        for (int v = 0; v < 5; ++v) { float cv = (v < 4) ? p.c[v * 1024 + k] : p.cctx[k]; acc[v] += silu_f(cv) * wv; }
      }
#pragma unroll
      for (int v = 0; v < 5; ++v) if (kq < 4) red[(kq * 64 + (TIDX & 63)) * 5 + v] = acc[v];
      __syncthreads();
      if (kq == 0) {
#pragma unroll
        for (int v = 0; v < 5; ++v) {
          float s = p.b_ada[l][col];
          for (int q = 0; q < 4; ++q) s += red[(q * 64 + TIDX) * 5 + v];
          MODV(p, l, v)[col] = s;
        }
      }
      __syncthreads();
    }
  }
  {
    float2* rt = WSP<float2>(p, OFF_ROPE);
    for (int i = blockIdx.x * blockDim.x + TIDX; i < S * 32; i += gridDim.x * blockDim.x) {
      const int s = i >> 5, pr = i & 31, f = pr & 15;
      const float pos = (pr < 16) ? (float)(s / 64) : (float)(s % 64);
      const float inv = exp2f(-(float)f * 0.830482023721841f);
      const float ang = pos * inv;
      float tr = ang * 0.15915494309189535f; tr = tr - floorf(tr);
      rt[i] = make_float2(__builtin_amdgcn_cosf(tr), __builtin_amdgcn_sinf(tr));
    }
  }
}

DI void phase_rowwise(const P& p, int l, const bf16_t* __restrict__ Y) {
  const int lane = TIDX & 63, wpb = blockDim.x >> 6;
  bf16_t* H = WSP<bf16_t>(p, OFF_HB);
  float* Xc = WSP<float>(p, OFF_XC);
  float4 gpo[4], gpr[4], gtv[4], shv[4], scv[4];
#pragma unroll
  for (int i = 0; i < 4; ++i) {
    const int c0 = i * 256 + lane * 4;
    gpo[i] = l > 0 ? *(const float4*)(p.g_post[l > 0 ? l - 1 : 0] + c0) : make_float4(0.f, 0.f, 0.f, 0.f);
    gpr[i] = l < 4 ? *(const float4*)(p.g_pre[l < 4 ? l : 0] + c0) : make_float4(0.f, 0.f, 0.f, 0.f);
    gtv[i] = shv[i] = scv[i] = make_float4(0.f, 0.f, 0.f, 0.f);
  }
  int cur_bi = -1;
  for (int row = blockIdx.x * wpb + (TIDX >> 6); row < NT; row += gridDim.x * wpb) {
    const bool isc = row >= NLAT;
    if (l == 4 && isc) continue;
    const int bi = isc ? 4 : row / S;
    if (bi != cur_bi) {
      cur_bi = bi;
#pragma unroll
      for (int i = 0; i < 4; ++i) {
        const int c0 = i * 256 + lane * 4;
        if (l > 0) gtv[i] = *(const float4*)(MODV(p, l - 1, bi) + 2048 + c0);
        if (l < 4) { shv[i] = *(const float4*)(MODV(p, l, bi) + c0); scv[i] = *(const float4*)(MODV(p, l, bi) + 1024 + c0); }
      }
    }
    const float* xs = (l <= 1) ? (isc ? p.ctx + (size_t)(row - NLAT) * D : p.x + (size_t)row * D)
                               : (isc ? Xc + (size_t)(row - NLAT) * D : p.out + (size_t)row * D);
    float4 xv[4];
#pragma unroll
    for (int i = 0; i < 4; ++i) xv[i] = *(const float4*)(xs + i * 256 + lane * 4);
    if (l > 0) {
      float4 yv[4]; float ss = 0;
#pragma unroll
      for (int i = 0; i < 4; ++i) { const ushort4 u = *(const ushort4*)(Y + (size_t)row * D + i * 256 + lane * 4); yv[i] = make_float4(bf2f(u.x), bf2f(u.y), bf2f(u.z), bf2f(u.w)); ss += yv[i].x * yv[i].x + yv[i].y * yv[i].y + yv[i].z * yv[i].z + yv[i].w * yv[i].w; }
      ss = wave_sum(ss);
      const float rs = rsqrtf(ss * (1.f / D) + EPS);
      float* xd = isc ? Xc + (size_t)(row - NLAT) * D : p.out + (size_t)row * D;
#pragma unroll
      for (int i = 0; i < 4; ++i) {
        const int c0 = i * 256 + lane * 4;
        const float4 g = gtv[i], q = gpo[i];
        xv[i].x += g.x * yv[i].x * rs * q.x; xv[i].y += g.y * yv[i].y * rs * q.y; xv[i].z += g.z * yv[i].z * rs * q.z; xv[i].w += g.w * yv[i].w * rs * q.w;
        *(float4*)(xd + c0) = xv[i];
      }
    }
    if (l < 4) {
      float ss = 0;
#pragma unroll
      for (int i = 0; i < 4; ++i) ss += xv[i].x * xv[i].x + xv[i].y * xv[i].y + xv[i].z * xv[i].z + xv[i].w * xv[i].w;
      ss = wave_sum(ss);
      const float rs = rsqrtf(ss * (1.f / D) + EPS);
#pragma unroll
      for (int i = 0; i < 4; ++i) {
        const int c0 = i * 256 + lane * 4;
        const float4 a = shv[i], b = scv[i], g = gpr[i];
        ushort4 o;
        o.x = f2bf(xv[i].x * rs * g.x * (1.f + b.x) + a.x); o.y = f2bf(xv[i].y * rs * g.y * (1.f + b.y) + a.y);
        o.z = f2bf(xv[i].z * rs * g.z * (1.f + b.z) + a.z); o.w = f2bf(xv[i].w * rs * g.w * (1.f + b.w) + a.w);
        *(ushort4*)(H + (size_t)row * D + c0) = o;
      }
    }
  }
}

enum { M_IN_GQA = 0, M_IN_MLA = 1, M_UQ = 2, M_UKV = 3, M_IN_LSTM = 4, M_OUT = 5 };
DI void rope4(const P& p, int row, int d, float* v, bool hp = false, float4 pre = make_float4(1.f, 0.f, 1.f, 0.f)) {
  if (row >= NLAT) return;
  float4 cs;
  if (hp) cs = pre; else { const int s = row & (S - 1); cs = *(const float4*)(WSP<float2>(p, OFF_ROPE) + s * 32 + (d >> 1)); }
  const float a0 = v[0] * cs.x - v[1] * cs.y, a1 = v[0] * cs.y + v[1] * cs.x;
  const float a2 = v[2] * cs.z - v[3] * cs.w, a3 = v[2] * cs.w + v[3] * cs.z;
  v[0] = a0; v[1] = a1; v[2] = a2; v[3] = a3;
}
template <int MODE> DI bool rope_group(int col, int& d) {
  if constexpr (MODE == M_IN_GQA) { d = col & 63; return col < 1280; }
  else if constexpr (MODE == M_IN_MLA) { d = col - 384; return col >= 384 && col < 448; }
  else if constexpr (MODE == M_UQ) { const int dd = col % 192; d = dd - 128; return dd >= 128; }
  else { d = 0; return false; }
}
typedef __attribute__((ext_vector_type(4))) unsigned u32x4_t;
DI unsigned pack2rne(float a, float b) { return (unsigned)f2bf(a) | ((unsigned)f2bf(b) << 16); }
DI void st4(bf16_t* dst, const float* v) { ushort4 o; o.x = f2bf(v[0]); o.y = f2bf(v[1]); o.z = f2bf(v[2]); o.w = f2bf(v[3]); *(ushort4*)dst = o; }
template <int MODE> DI bf16_t* epi_calc(const P& p, int row, int col, float* v, bool hp = false, float4 rpre = make_float4(1.f, 0.f, 1.f, 0.f)) {
  if constexpr (MODE == M_IN_GQA) {
    if (col < 1024) { rope4(p, row, col & 63, v, hp, rpre); for (int i = 0; i < 4; ++i) v[i] *= 0.125f * 1.4426950408889634f;   return WSP<bf16_t>(p, GQ_QB) + (size_t)row * 1024 + col; }
    else if (col < 1280) { const int c = col - 1024; rope4(p, row, c & 63, v, hp, rpre); return WSP<bf16_t>(p, GQ_KB) + (size_t)row * 256 + c; }
    else if (col < 1536) { const int c = col - 1280; bf16_t* vt = WSP<bf16_t>(p, GQ_VT); const int vp = vpos32(row); for (int i = 0; i < 4; ++i) vt[(size_t)(c + i) * NT + vp] = f2bf(v[i]); return nullptr; }
    else { const int c = col - 1536; for (int i = 0; i < 4; ++i) v[i] = silu_f(v[i]); return WSP<bf16_t>(p, GQ_G) + (size_t)row * 1024 + c; }
  } else if constexpr (MODE == M_IN_MLA) {
    if (col < 256) return WSP<bf16_t>(p, ML_QA) + (size_t)row * 256 + col;
    else if (col < 384) return WSP<bf16_t>(p, ML_KVA) + (size_t)row * 128 + (col - 256);
    else if (col < 448) { const int d = col - 384; rope4(p, row, d, v, hp, rpre); bf16_t* kb = WSP<bf16_t>(p, ML_KB) + (size_t)row * 1536 + 128 + d; for (int h = 0; h < 8; ++h) st4(kb + h * 192, v); return nullptr; }
    else { const int c = col - 448; for (int i = 0; i < 4; ++i) v[i] = silu_f(v[i]); return WSP<bf16_t>(p, ML_G) + (size_t)row * 1024 + c; }
  } else if constexpr (MODE == M_UQ) {
    const int d = col % 192;
    if (d >= 128) rope4(p, row, d - 128, v, hp, rpre);
    for (int i = 0; i < 4; ++i) v[i] *= 0.07216878364870323f * 1.4426950408889634f;
    return WSP<bf16_t>(p, ML_QB) + (size_t)row * 1536 + col;
  } else if constexpr (MODE == M_UKV) {
    const int h = col >> 8, e = col & 255;
    if (e < 128) return WSP<bf16_t>(p, ML_KB) + (size_t)row * 1536 + h * 192 + e;
    else { bf16_t* vt = WSP<bf16_t>(p, ML_VT); const int vp = vpos32(row); for (int i = 0; i < 4; ++i) vt[(size_t)(h * 128 + e - 128 + i) * NT + vp] = f2bf(v[i]); return nullptr; }
  } else if constexpr (MODE == M_IN_LSTM) {
    if (col < 1024) return WSP<bf16_t>(p, LS_QKRAW) + (size_t)row * 1024 + col;
    else if (col < 2048) { bf16_t* vt = WSP<bf16_t>(p, LS_VT); const int vp = vpos(row); for (int i = 0; i < 4; ++i) vt[(size_t)(col - 1024 + i) * NT + vp] = f2bf(v[i]); return nullptr; }
    else if (col < 3072) { for (int i = 0; i < 4; ++i) v[i] = sigmoid_f(v[i]); return WSP<bf16_t>(p, LS_OB) + (size_t)row * 1024 + (col - 2048); }
    else if (col < 4096) { for (int i = 0; i < 4; ++i) v[i] = silu_f(v[i]); return WSP<bf16_t>(p, LS_G) + (size_t)row * 1024 + (col - 3072); }
    else { float* g = WSP<float>(p, LS_GATES) + (size_t)row * 16 + (col - 4096); for (int i = 0; i < 4; ++i) g[i] = v[i] + p.b_gate[col - 4096 + i]; return nullptr; }
  }
  return nullptr;
}
template <int MODE> DI void epi(const P& p, int row, int col, float* v) { bf16_t* d = epi_calc<MODE>(p, row, col, v); if (d) st4(d, v); }
template <int MODE> DI void epi8(const P& p, bf16_t* Y, int row, int col, float* v, bool hp = false, float4 rp0 = make_float4(1.f, 0.f, 1.f, 0.f), float4 rp1 = make_float4(1.f, 0.f, 1.f, 0.f)) {
  bf16_t *d0, *d1;
  if constexpr (MODE == M_OUT) { d0 = Y + (size_t)row * 1024 + col; d1 = d0 + 4; }
  else { d0 = epi_calc<MODE>(p, row, col, v, hp, rp0); d1 = epi_calc<MODE>(p, row, col + 4, v + 4, hp, rp1); }
  if (d0 != nullptr && d1 == d0 + 4) {
    u32x4_t w = {pack2rne(v[0], v[1]), pack2rne(v[2], v[3]), pack2rne(v[4], v[5]), pack2rne(v[6], v[7])};
    *(u32x4_t*)d0 = w;
  } else { if (d0) st4(d0, v); if (d1) st4(d1, v + 4); }
}
DI void epi_out(bf16_t* Y, int row, int col, const float* v) { st4(Y + (size_t)row * 1024 + col, v); }

DI void unpack8(uint4 a, float* f) {
  f[0] = __uint_as_float(a.x << 16); f[1] = __uint_as_float(a.x & 0xffff0000u); f[2] = __uint_as_float(a.y << 16); f[3] = __uint_as_float(a.y & 0xffff0000u);
  f[4] = __uint_as_float(a.z << 16); f[5] = __uint_as_float(a.z & 0xffff0000u); f[6] = __uint_as_float(a.w << 16); f[7] = __uint_as_float(a.w & 0xffff0000u);
}
template <int MODE, bool ROWSCALE>
__global__ __launch_bounds__(256) void k_gemm_naive(P p, const bf16_t* __restrict__ A, int lda, const bf16_t* __restrict__ Wt, int K, int N, int M, bf16_t* Y) {
  const int n4 = N >> 2; const long total = (long)M * n4;
  for (long idx = (long)blockIdx.x * 256 + TIDX; idx < total; idx += (long)gridDim.x * 256) {
    const int col = (int)(idx % n4) * 4, row = (int)(idx / n4);
    float acc[4] = {0, 0, 0, 0}, ss = 0;
    const bf16_t* a = A + (size_t)row * lda; const bf16_t* w = Wt + (size_t)col * K;
    for (int k = 0; k < K; k += 8) {
      float af[8], wf[8]; unpack8(*(const uint4*)(a + k), af);
      if (ROWSCALE) { for (int j = 0; j < 8; ++j) ss += af[j] * af[j]; }
#pragma unroll
      for (int i = 0; i < 4; ++i) { unpack8(*(const uint4*)(w + (size_t)i * K + k), wf); for (int j = 0; j < 8; ++j) acc[i] += af[j] * wf[j]; }
    }
    if (ROWSCALE) { const float rs = rsqrtf(ss / (float)K + EPS); for (int i = 0; i < 4; ++i) acc[i] *= rs; }
    if constexpr (MODE == M_OUT) epi_out(Y, row, col, acc); else epi<MODE>(p, row, col, acc);
  }
}

template <int KIND>
__global__ __launch_bounds__(256) void k_attn_naive(P p, const float* __restrict__ sink, int row_begin, int row_end) {
  constexpr int DQK = KIND ? 192 : 64, DV = KIND ? 128 : 64, HQ = KIND ? 8 : 16, GRP = KIND ? 1 : 4;
  constexpr int LDQ = HQ * DQK, LDK = (HQ / GRP) * DQK;
  const bf16_t* Qb = WSP<bf16_t>(p, KIND ? ML_QB : GQ_QB); const bf16_t* Kb = WSP<bf16_t>(p, KIND ? ML_KB : GQ_KB);
  const bf16_t* Vt = WSP<bf16_t>(p, KIND ? ML_VT : GQ_VT); const bf16_t* G = WSP<bf16_t>(p, KIND ? ML_G : GQ_G);
  bf16_t* O = WSP<bf16_t>(p, OFF_HB);
  __shared__ float qs[4][DQK];
  const int lane = TIDX & 63, wv = TIDX >> 6;
  const long nitems = (long)(row_end - row_begin) * HQ;
  for (long it = (long)blockIdx.x * 4 + wv; it < nitems; it += (long)gridDim.x * 4) {
    const int row = row_begin + (int)(it / HQ), h = (int)(it % HQ), kvh = h / GRP;
    const bool isc = row >= NLAT;
    int a0 = 0, nA = 0, c0;
    if (!isc) { const int b = row / S, s = row % S; c0 = NLAT + b * L;
      if (KIND == 0) { int lo = s - 128 < 0 ? 0 : s - 128, hi = s + 129 > S ? S : s + 129; a0 = b * S + lo; nA = hi - lo; } else { a0 = b * S; nA = S; } }
    else c0 = NLAT + ((row - NLAT) / L) * L;
    const int nk = nA + L;
    for (int d = lane; d < DQK; d += 64) qs[wv][d] = bf2f(Qb[(size_t)row * LDQ + h * DQK + d]);
    __builtin_amdgcn_s_waitcnt(0); __builtin_amdgcn_wave_barrier();
    float m = -1e30f;
    for (int j = lane; j < nk; j += 64) {
      const int kr = j < nA ? a0 + j : c0 + (j - nA);
      const bf16_t* kp = Kb + (size_t)kr * LDK + kvh * DQK; float s = 0;
      for (int d = 0; d < DQK; d += 8) { float kf[8]; unpack8(*(const uint4*)(kp + d), kf); for (int e = 0; e < 8; ++e) s += qs[wv][d + e] * kf[e]; }
      m = fmaxf(m, s);
    }
    m = wave_max(m);
    float lsum = 0;
    if (KIND == 0) { const float sk = sink[h] * 1.4426950408889634f; m = fmaxf(m, sk); }
    float acc[DV];
#pragma unroll
    for (int d = 0; d < DV; ++d) acc[d] = 0;
    for (int j = lane; j < nk; j += 64) {
      const int kr = j < nA ? a0 + j : c0 + (j - nA);
      const bf16_t* kp = Kb + (size_t)kr * LDK + kvh * DQK; float s = 0;
      for (int d = 0; d < DQK; d += 8) { float kf[8]; unpack8(*(const uint4*)(kp + d), kf); for (int e = 0; e < 8; ++e) s += qs[wv][d + e] * kf[e]; }
      const float pe = exp2f(s - m); lsum += pe;
      const bf16_t* vp = Vt + (size_t)(kvh * DV) * NT + vpos32(kr);
#pragma unroll
      for (int d = 0; d < DV; ++d) acc[d] += pe * bf2f(vp[(size_t)d * NT]);
    }
    lsum = wave_sum(lsum);
    if (KIND == 0) lsum += exp2f(sink[h] * 1.4426950408889634f - m);
    const float inv = 1.f / lsum;
    float o0 = 0, o1 = 0;
#pragma unroll
    for (int d = 0; d < DV; ++d) { const float t = wave_sum(acc[d]); if ((d & 63) == lane) { if (d < 64) o0 = t; else o1 = t; } }
    { const size_t oi = (size_t)row * 1024 + h * DV + lane; O[oi] = f2bf(o0 * inv * bf2f(G[oi])); if (DV > 64) O[oi + 64] = f2bf(o1 * inv * bf2f(G[oi + 64])); }
    __builtin_amdgcn_wave_barrier();
  }
}

DI int chunk_base(int b, int dir, int c) {
  if (c < 2) { const int blk = dir ? 1 - c : c; return NLAT + b * L + blk * 128; }
  const int cc = c - 2, blk = dir ? 63 - cc : cc; return b * S + blk * 128;
}
DI void phase_conv(const P& p) {
  const bf16_t* src = WSP<bf16_t>(p, LS_QKRAW); bf16_t* dst = WSP<bf16_t>(p, OFF_HB);
  constexpr int RCH = 33, NCHK = NT / RCH;
  static_assert(NCHK * RCH == NT, "conv chunking");
  const int tid = TIDX, cg = tid & 127, c0 = cg * 8, grp = tid >> 7, ngrp = blockDim.x >> 7;
  float wt[5][8];
#pragma unroll
  for (int j = 0; j < 5; ++j) { const float4 a = *(const float4*)(p.conv + j * 1024 + c0), b = *(const float4*)(p.conv + j * 1024 + c0 + 4); wt[j][0] = a.x; wt[j][1] = a.y; wt[j][2] = a.z; wt[j][3] = a.w; wt[j][4] = b.x; wt[j][5] = b.y; wt[j][6] = b.z; wt[j][7] = b.w; }
  const float osc = c0 >= 512 ? 0.08838834764831845f : 1.f;
  for (int chunk = blockIdx.x * ngrp + grp; chunk < NCHK; chunk += gridDim.x * ngrp) {
    const int r0 = chunk * RCH;
    float win[5][8];
#define CV_LOAD(dstv, r_) do { int rr_ = (r_); rr_ = rr_ < 0 ? 0 : (rr_ >= NT ? NT - 1 : rr_); float f_[8]; unpack8(*(const uint4*)(src + (size_t)rr_ * 1024 + c0), f_); \
      _Pragma("unroll") for (int e = 0; e < 8; ++e) dstv[e] = f_[e]; } while (0)
    CV_LOAD(win[0], r0 - 2); CV_LOAD(win[1], r0 - 1); CV_LOAD(win[2], r0); CV_LOAD(win[3], r0 + 1);
    for (int i = 0; i < RCH; ++i) {
      const int row = r0 + i;
      CV_LOAD(win[4], row + 2);
      int lo, hi;
      if (row < NLAT) { lo = (row / S) * S; hi = lo + S; } else { lo = NLAT + ((row - NLAT) / L) * L; hi = lo + L; }
      float acc[8];
#pragma unroll
      for (int e = 0; e < 8; ++e) acc[e] = 0.f;
#pragma unroll
      for (int j = 0; j < 5; ++j) {
        const int r = row + j - 2;
        const float mk = (r >= lo && r < hi) ? 1.f : 0.f;
#pragma unroll
        for (int e = 0; e < 8; ++e) acc[e] += mk * win[j][e] * wt[j][e];
      }
      u32x4_t o;
#pragma unroll
      for (int q = 0; q < 4; ++q) o[q] = pack2rne(silu_f(acc[2 * q]) * osc, silu_f(acc[2 * q + 1]) * osc);
      *(u32x4_t*)(dst + (size_t)row * 1024 + c0) = o;
#pragma unroll
      for (int j = 0; j < 4; ++j)
#pragma unroll
        for (int e = 0; e < 8; ++e) win[j][e] = win[j + 1][e];
    }
  }
}
DI void phase_prep(const P& p) {
  const float* gates = WSP<float>(p, LS_GATES);
  float *CUM = WSP<float>(p, LS_CUM), *PM = WSP<float>(p, LS_PM), *BV = WSP<float>(p, LS_BV), *EE = WSP<float>(p, LS_EE);
  float *TOT = WSP<float>(p, LS_TOT), *MLOC = WSP<float>(p, LS_MLOC);
  const int lane = TIDX & 63, wpb = blockDim.x >> 6;
  for (int it = blockIdx.x * wpb + (TIDX >> 6); it < NITEM; it += gridDim.x * wpb) {
    const int c = it % NCH, dir = (it / NCH) & 1, h = (it / (NCH * 2)) & 3, b = it / (NCH * 8);
    const int base = chunk_base(b, dir, c);
    const int r0 = base + (dir ? 127 - lane : lane), r1 = base + (dir ? 63 - lane : 64 + lane);
    const float f0 = gates[(size_t)r0 * 16 + (2 * dir + 1) * 4 + h], f1 = gates[(size_t)r1 * 16 + (2 * dir + 1) * 4 + h];
    const float i0 = gates[(size_t)r0 * 16 + (2 * dir) * 4 + h], i1 = gates[(size_t)r1 * 16 + (2 * dir) * 4 + h];
    float c0v = fminf(f0, 0.f) - log1pf(__expf(-fabsf(f0))), c1v = fminf(f1, 0.f) - log1pf(__expf(-fabsf(f1)));
    for (int o = 1; o < 64; o <<= 1) { float t0 = __shfl_up(c0v, o), t1 = __shfl_up(c1v, o); if (lane >= o) { c0v += t0; c1v += t1; } }
    c1v += __shfl(c0v, 63);
    const float tot = __shfl(c1v, 63);
    const float b0 = i0 - c0v, b1 = i1 - c1v;
    float p0 = b0, p1 = b1;
    for (int o = 1; o < 64; o <<= 1) { float t0 = __shfl_up(p0, o), t1 = __shfl_up(p1, o); if (lane >= o) { p0 = fmaxf(p0, t0); p1 = fmaxf(p1, t1); } }
    p1 = fmaxf(p1, __shfl(p0, 63));
    const float bmax = __shfl(p1, 63);
    const size_t o0 = ((size_t)dir * 4 + h) * NT + r0, o1 = ((size_t)dir * 4 + h) * NT + r1;
    CUM[o0] = c0v; CUM[o1] = c1v; PM[o0] = p0; PM[o1] = p1; BV[o0] = b0; BV[o1] = b1; EE[o0] = __expf(b0 - bmax); EE[o1] = __expf(b1 - bmax);
    if (lane == 0) { TOT[it] = tot; MLOC[it] = tot + bmax; }
  }
}
__global__ __launch_bounds__(256) void k_lstm_scan_naive(P p) {
  const bf16_t* QK = WSP<bf16_t>(p, OFF_HB); const bf16_t* Vt = WSP<bf16_t>(p, LS_VT);
  const float *EE = WSP<float>(p, LS_EE), *TOT = WSP<float>(p, LS_TOT), *MLOC = WSP<float>(p, LS_MLOC);
  float *MST = WSP<float>(p, LS_MST), *NST = WSP<float>(p, LS_NST); bf16_t* CST = WSP<bf16_t>(p, LS_CST);
  const long idx = (long)blockIdx.x * 256 + TIDX;
  const int k = idx & 127, v = (idx >> 7) & 255, bhd = (int)(idx >> 15), dir = bhd & 1, h = (bhd >> 1) & 3, b = bhd >> 3;
  float C = 0, n = 0, m = -1e30f;
  for (int c = 0; c < NCH; ++c) {
    const int it = bhd * NCH + c, base = chunk_base(b, dir, c);
    CST[((size_t)it * 256 + v) * 128 + k] = f2bf(C);
    if (v == 0) { NST[(size_t)it * 128 + k] = n; if (k == 0) MST[it] = m; }
    const float tot = TOT[it], ml = MLOC[it], mn = fmaxf(tot + m, ml), a = __expf(tot + m - mn), bb = __expf(ml - mn);
    float acc = 0, nacc = 0;
    const float* ee = EE + ((size_t)dir * 4 + h) * NT + base;
    const bf16_t* vp = Vt + (size_t)(h * 256 + v) * NT; const bf16_t* kp = QK + (size_t)base * 1024 + 512 + h * 128 + k;
    for (int t = 0; t < 128; ++t) { const float e = ee[t], kv = bf2f(kp[(size_t)t * 1024]); acc += e * bf2f(vp[vpos(base + t)]) * kv; nacc += e * kv; }
    C = a * C + bb * acc; n = a * n + bb * nacc; m = mn;
  }
}
__global__ __launch_bounds__(256) void k_lstm_out_naive(P p) {
  extern __shared__ float sm[];
  float (*Sp)[128][129] = (float (*)[128][129])sm;
  float* den = sm + 2 * 128 * 129; float* at = den + 256; float* fl = at + 256; float* mxs = fl + 256;
  const bf16_t* QK = WSP<bf16_t>(p, OFF_HB); const bf16_t* Vt = WSP<bf16_t>(p, LS_VT);
  const float *CUM = WSP<float>(p, LS_CUM), *PM = WSP<float>(p, LS_PM), *BV = WSP<float>(p, LS_BV);
  const float *MST = WSP<float>(p, LS_MST), *NST = WSP<float>(p, LS_NST); const bf16_t* CST = WSP<bf16_t>(p, LS_CST);
  bf16_t* HS = WSP<bf16_t>(p, LS_QKRAW);
  const int tid = TIDX;
  const int mb = blockIdx.x % NCH, h = (blockIdx.x / NCH) & 3, b = blockIdx.x / (NCH * 4);
  const int base = mb < 2 ? NLAT + b * L + mb * 128 : b * S + (mb - 2) * 128;
  int its[2];
  for (int dir = 0; dir < 2; ++dir) { const int c = mb < 2 ? (dir ? 1 - mb : mb) : 2 + (dir ? 63 - (mb - 2) : mb - 2); its[dir] = ((b * 4 + h) * 2 + dir) * NCH + c; }
  { const int dir = tid >> 7, i = tid & 127; const float mst = MST[its[dir]]; const size_t o = ((size_t)dir * 4 + h) * NT + base + i;
    const float mx = fmaxf(mst, PM[o]); mxs[tid] = mx; at[tid] = __expf(mst - mx); fl[tid] = __expf(-CUM[o] - mx); }
  __syncthreads();
  for (int e = tid; e < 2 * 128 * 128; e += 256) {
    const int dir = e >> 14, i = (e >> 7) & 127, j = e & 127;
    float s = 0;
    if (dir ? (j >= i) : (j <= i)) {
      const bf16_t* qp = QK + (size_t)(base + i) * 1024 + h * 128; const bf16_t* kp = QK + (size_t)(base + j) * 1024 + 512 + h * 128;
      for (int d = 0; d < 128; d += 8) { float qf[8], kf[8]; unpack8(*(const uint4*)(qp + d), qf); unpack8(*(const uint4*)(kp + d), kf); for (int u = 0; u < 8; ++u) s += qf[u] * kf[u]; }
      s *= __expf(BV[((size_t)dir * 4 + h) * NT + base + j] - mxs[dir * 128 + i]);
    }
    Sp[dir][i][j] = s;
  }
  __syncthreads();
  { const int dir = tid >> 7, i = tid & 127; float s = 0; for (int j = 0; j < 128; ++j) s += Sp[dir][i][j];
    float nq = 0; const bf16_t* qp = QK + (size_t)(base + i) * 1024 + h * 128; const float* ns = NST + (size_t)its[dir] * 128;
    for (int k = 0; k < 128; ++k) nq += ns[k] * bf2f(qp[k]);
    den[tid] = s + at[tid] * nq; }
  __syncthreads();
  { const int v = tid; const bf16_t* vp = Vt + (size_t)(h * 256 + v) * NT;
    for (int i = 0; i < 128; ++i) {
      float hs = 0; const bf16_t* qp = QK + (size_t)(base + i) * 1024 + h * 128;
      for (int dir = 0; dir < 2; ++dir) {
        float num = 0; for (int j = 0; j < 128; ++j) num += Sp[dir][i][j] * bf2f(vp[vpos(base + j)]);
        float cq = 0; const bf16_t* cp = CST + ((size_t)its[dir] * 256 + v) * 128;
        for (int k = 0; k < 128; k += 8) { float cf[8], qf[8]; unpack8(*(const uint4*)(cp + k), cf); unpack8(*(const uint4*)(qp + k), qf); for (int u = 0; u < 8; ++u) cq += cf[u] * qf[u]; }
        num += at[dir * 128 + i] * cq;
        hs += num / fmaxf(fabsf(den[dir * 128 + i]), fl[dir * 128 + i]);
      }
      HS[(size_t)(base + i) * 1024 + h * 256 + v] = f2bf(hs);
    } }
}
__global__ __launch_bounds__(256) void k_lstm_finish_naive(P p) {
  const bf16_t* HS = WSP<bf16_t>(p, LS_QKRAW); const bf16_t* OB = WSP<bf16_t>(p, LS_OB); const bf16_t* G = WSP<bf16_t>(p, LS_G); bf16_t* O = WSP<bf16_t>(p, OFF_HB);
  const int lane = TIDX & 63;
  for (int row = blockIdx.x * 4 + (TIDX >> 6); row < NT; row += gridDim.x * 4) {
    const size_t o = (size_t)row * 1024 + lane * 16; float hh[16], ss = 0;
    for (int i = 0; i < 16; ++i) { hh[i] = bf2f(HS[o + i]) * bf2f(OB[o + i]); ss += hh[i] * hh[i]; }
    for (int q = 1; q < 16; q <<= 1) ss += __shfl_xor(ss, q);
    const float rs = rsqrtf(ss * (1.f / 256) + EPS);
    for (int i = 0; i < 16; ++i) O[o + i] = f2bf(hh[i] * rs * p.g_head[lane * 16 + i] * bf2f(G[o + i]));
  }
}

typedef __attribute__((ext_vector_type(8))) short bf16x8;
typedef __attribute__((ext_vector_type(16))) float f32x16;
typedef __attribute__((ext_vector_type(4))) float f32x4;
typedef __bf16 bf2_t __attribute__((ext_vector_type(2)));
typedef float f2_t __attribute__((ext_vector_type(2)));
typedef __attribute__((ext_vector_type(4))) unsigned u32x4;
#define MFMA(a, b, c) __builtin_amdgcn_mfma_f32_32x32x16_bf16((a), (b), (c), 0, 0, 0)
DI unsigned pack2(float a, float b) { f2_t v = {a, b}; bf2_t r = __builtin_convertvector(v, bf2_t); return __builtin_bit_cast(unsigned, r); }
constexpr int SMEM_BYTES = 147456;
constexpr int GT_F = 128, GT_T = 256, GBK = 64, G_STAGE = (GT_F + GT_T) * 128;
static_assert(3 * G_STAGE <= SMEM_BYTES, "gemm lds");
#define GLDS16(gp, lp) __builtin_amdgcn_global_load_lds((const unsigned*)(gp), (unsigned __attribute__((address_space(3)))*)(lp), 16, 0, 0)
#define RAW_BARRIER() do { asm volatile("s_waitcnt lgkmcnt(0)" ::: "memory"); __builtin_amdgcn_s_barrier(); asm volatile("" ::: "memory"); } while (0)
#define WAIT_VM(n) asm volatile("s_waitcnt vmcnt(" #n ")" ::: "memory")

template <int MODE, bool ROWSCALE>
DI void phase_gemm(const P& p, const bf16_t* __restrict__ A, int lda, const bf16_t* __restrict__ Wt, int K, int N, int M, bf16_t* Y, char* smem) {
  const int tid = TIDX, lane = tid & 63, w = __builtin_amdgcn_readfirstlane(tid >> 6), r = lane & 31, h = lane >> 5;
  const int wf = w & 1, wt = w >> 1;
  const int ntn = (N + GT_F - 1) / GT_F, ntm = M / GT_T, ntiles = ntn * ntm, nk = K / GBK;
  const int lrow = lane >> 3, lcp = lane & 7;
  const int r16 = lane & 15, kq = lane >> 4;
  const int fsw = (r16 >> 1) & 7;
  const int G = gridDim.x, first = vblock();
  const int nmy = first < ntiles ? (ntiles - 1 - first) / G + 1 : 0, total = nmy * nk;
  const bf16_t* gw[2]; const bf16_t* ga[4];
#define G_SETPTR(tile_) do { const int sr_ = (tile_) / (4 * ntn), rem_ = (tile_) - sr_ * 4 * ntn, n0_ = (rem_ >> 2) * GT_F, m0_ = (sr_ * 4 + (rem_ & 3)) * GT_T; \
    _Pragma("unroll") for (int i = 0; i < 2; ++i) { const int row = 8 * (w + 8 * i) + lrow; \
      const int prow = (row & 64) | (((row >> 5) & 1) << 5) | (((row >> 2) & 3) << 3) | (((row >> 4) & 1) << 2) | (row & 3);     \
      int n = n0_ + prow; n = n < N ? n : N - 1; gw[i] = Wt + (size_t)n * K + ((lcp ^ ((row >> 1) & 7)) << 3); } \
    _Pragma("unroll") for (int i = 0; i < 4; ++i) { const int row = 8 * (w + 8 * i) + lrow; ga[i] = A + (size_t)(m0_ + row) * lda + ((lcp ^ ((row >> 1) & 7)) << 3); } } while (0)
#define G_ISSUE() do { char* st_ = smem + ibuf * G_STAGE; \
    _Pragma("unroll") for (int i = 0; i < 2; ++i) GLDS16(gw[i] + is_kt * GBK, st_ + (w + 8 * i) * 1024); \
    _Pragma("unroll") for (int i = 0; i < 4; ++i) GLDS16(ga[i] + is_kt * GBK, st_ + GT_F * 128 + (w + 8 * i) * 1024); \
    ibuf = ibuf == 2 ? 0 : ibuf + 1; \
    if (++is_kt == nk) { is_kt = 0; is_tile += G; if (is_tile < ntiles) G_SETPTR(is_tile); } } while (0)
  int is_tile = first, is_kt = 0, ibuf = 0, buf = 0, g = 0;
  if (total > 0) { G_SETPTR(first); G_ISSUE(); if (total > 1) G_ISSUE(); }
  for (int tile = first; tile < ntiles; tile += G) {
    const int sr = tile / (4 * ntn), rem = tile - sr * 4 * ntn, tn = rem >> 2, tm = sr * 4 + (rem & 3), n0 = tn * GT_F, m0 = tm * GT_T;
    f32x4 acc[4][4];
#pragma unroll
    for (int i = 0; i < 4; ++i)
#pragma unroll
      for (int j = 0; j < 4; ++j)
#pragma unroll
        for (int e = 0; e < 4; ++e) acc[i][j][e] = 0.f;
    float ssq[4] = {0.f, 0.f, 0.f, 0.f};
    bool vtile = false;
    if constexpr (MODE == M_IN_GQA) vtile = n0 >= 1280 && n0 < 1536;
    if constexpr (MODE == M_UKV) vtile = (n0 & 255) == 128;
    if constexpr (MODE == M_IN_LSTM) vtile = n0 >= 1024 && n0 < 2048;
#define G_KLOOP(SWAP_) \
    _Pragma("clang loop unroll(disable)") \
    for (int kt = 0; kt < nk; ++kt, ++g) { \
      if (g + 1 < total) WAIT_VM(6); else WAIT_VM(0); \
      RAW_BARRIER(); \
      if (g + 2 < total) G_ISSUE(); \
      const char* Ws = smem + buf * G_STAGE + (wf * 64 + r16) * 128; const char* As = smem + buf * G_STAGE + (GT_F + wt * 64 + r16) * 128; \
      _Pragma("unroll") for (int ks = 0; ks < 2; ++ks) { \
        const int co = ((4 * ks + kq) ^ fsw) << 4; \
        bf16x8 wfr[4], afr[4]; \
        _Pragma("unroll") for (int i = 0; i < 4; ++i) wfr[i] = *(const bf16x8*)(Ws + i * 16 * 128 + co); \
        _Pragma("unroll") for (int i = 0; i < 4; ++i) afr[i] = *(const bf16x8*)(As + i * 16 * 128 + co); \
        if constexpr (ROWSCALE) { _Pragma("unroll") for (int i = 0; i < 4; ++i) _Pragma("unroll") for (int j = 0; j < 8; ++j) { const float f = bf2f((bf16_t)afr[i][j]); ssq[i] += f * f; } } \
        _Pragma("unroll") for (int i = 0; i < 4; ++i) _Pragma("unroll") for (int j = 0; j < 4; ++j) \
          acc[i][j] = SWAP_ ? __builtin_amdgcn_mfma_f32_16x16x32_bf16(afr[j], wfr[i], acc[i][j], 0, 0, 0) : __builtin_amdgcn_mfma_f32_16x16x32_bf16(wfr[i], afr[j], acc[i][j], 0, 0, 0); \
      } \
      buf = buf == 2 ? 0 : buf + 1; \
    }
    if (vtile) { G_KLOOP(true) } else { G_KLOOP(false) }
    float rs[4] = {1.f, 1.f, 1.f, 1.f};
    if constexpr (ROWSCALE) {
#pragma unroll
      for (int i = 0; i < 4; ++i) { float t = ssq[i]; t += __shfl_xor(t, 16); t += __shfl_xor(t, 32); rs[i] = rsqrtf(t / (float)K + EPS); }
    }
    if (vtile) {
      bf16_t* vt = WSP<bf16_t>(p, MODE == M_IN_GQA ? GQ_VT : MODE == M_UKV ? ML_VT : LS_VT);
      const int tok0 = m0 + wt * 64;
#pragma unroll
      for (int fi = 0; fi < 4; ++fi) {
        const int col = n0 + wf * 64 + 32 * (fi >> 1) + 8 * ((r16 >> 2) & 3) + 4 * (fi & 1) + (r16 & 3);
        const int vr = MODE == M_IN_GQA ? col - 1280 : MODE == M_UKV ? (col >> 8) * 128 + (col & 255) - 128 : col - 1024;
        bf16_t* vrow = vt + (size_t)vr * NT + tok0;
        float sc[4][4];
#pragma unroll
        for (int ti = 0; ti < 4; ++ti)
#pragma unroll
          for (int r = 0; r < 4; ++r) sc[ti][r] = ROWSCALE ? __shfl(rs[ti], 4 * kq + r) : 1.f;
        if constexpr (MODE == M_IN_LSTM) {
          const int sw = ((kq & 1) << 1) | (kq >> 1);
#pragma unroll
          for (int ti = 0; ti < 4; ++ti) { float v[4] = {acc[fi][ti][0] * sc[ti][0], acc[fi][ti][1] * sc[ti][1], acc[fi][ti][2] * sc[ti][2], acc[fi][ti][3] * sc[ti][3]}; st4(vrow + 16 * ti + 4 * sw, v); }
        } else {
#pragma unroll
          for (int tp = 0; tp < 2; ++tp) {
            u32x4_t wv = {pack2rne(acc[fi][2 * tp][0] * sc[2 * tp][0], acc[fi][2 * tp][1] * sc[2 * tp][1]), pack2rne(acc[fi][2 * tp][2] * sc[2 * tp][2], acc[fi][2 * tp][3] * sc[2 * tp][3]),
                          pack2rne(acc[fi][2 * tp + 1][0] * sc[2 * tp + 1][0], acc[fi][2 * tp + 1][1] * sc[2 * tp + 1][1]), pack2rne(acc[fi][2 * tp + 1][2] * sc[2 * tp + 1][2], acc[fi][2 * tp + 1][3] * sc[2 * tp + 1][3])};
            *(u32x4_t*)(vrow + 32 * tp + 8 * kq) = wv;
          }
        }
      }
      continue;
    }
    float4 rp[4][2][2];
    bool roped[2]; int rd[2];
#pragma unroll
    for (int fp = 0; fp < 2; ++fp) { const int col = n0 + wf * 64 + fp * 32 + 8 * kq; roped[fp] = rope_group<MODE>(col, rd[fp]) && col < N; }
    if (__any(roped[0] || roped[1])) {
#pragma unroll
      for (int fp = 0; fp < 2; ++fp)
#pragma unroll
        for (int ti = 0; ti < 4; ++ti) {
          const int row = m0 + wt * 64 + ti * 16 + r16;
          const float4* t4 = (const float4*)(WSP<float2>(p, OFF_ROPE) + (row < NLAT ? (row & (S - 1)) : 0) * 32 + (roped[fp] ? (rd[fp] >> 1) : 0));
          rp[ti][fp][0] = t4[0]; rp[ti][fp][1] = t4[1];
        }
    } else {
#pragma unroll
      for (int fp = 0; fp < 2; ++fp)
#pragma unroll
        for (int ti = 0; ti < 4; ++ti) { rp[ti][fp][0] = make_float4(1.f, 0.f, 1.f, 0.f); rp[ti][fp][1] = make_float4(1.f, 0.f, 1.f, 0.f); }
    }
#pragma unroll
    for (int ti = 0; ti < 4; ++ti) {
      const int row = m0 + wt * 64 + ti * 16 + r16;
#pragma unroll
      for (int fp = 0; fp < 2; ++fp) {
        const int col = n0 + wf * 64 + fp * 32 + 8 * kq;
        if (col < N) {
          float v[8] = {acc[2 * fp][ti][0] * rs[ti], acc[2 * fp][ti][1] * rs[ti], acc[2 * fp][ti][2] * rs[ti], acc[2 * fp][ti][3] * rs[ti],
                        acc[2 * fp + 1][ti][0] * rs[ti], acc[2 * fp + 1][ti][1] * rs[ti], acc[2 * fp + 1][ti][2] * rs[ti], acc[2 * fp + 1][ti][3] * rs[ti]};
          epi8<MODE>(p, Y, row, col, v, roped[fp], rp[ti][fp][0], rp[ti][fp][1]);
        }
      }
    }
  }
  __syncthreads();
}

#define MFMA16(a, b, c) __builtin_amdgcn_mfma_f32_16x16x32_bf16((a), (b), (c), 0, 0, 0)
template <int KIND>
DI void phase_attn(const P& p, const float* __restrict__ sink, bool with_ctx, char* smem) {
  constexpr int DQK = KIND ? 192 : 64, DV = KIND ? 128 : 64, HQ = KIND ? 8 : 16, HKV = KIND ? 8 : 4;
  constexpr int LDQ = HQ * DQK, LDK = HKV * DQK, KROW = DQK * 2, VROW = 128;
  constexpr int KS_BYTES = 64 * KROW, STAGE = KS_BYTES + DV * VROW;
  constexpr int NKC = 64 * (DQK / 8) / 512, NVC = DV * 8 / 512, NKS = DQK / 32, NDT = DV / 16, KCPR = DQK / 8;
  static_assert(3 * STAGE <= SMEM_BYTES, "attn lds");
  constexpr float LOG2E = 1.4426950408889634f;
  const bf16_t* Qb = WSP<bf16_t>(p, KIND ? ML_QB : GQ_QB); const bf16_t* Kb = WSP<bf16_t>(p, KIND ? ML_KB : GQ_KB);
  const bf16_t* Vt = WSP<bf16_t>(p, KIND ? ML_VT : GQ_VT); const bf16_t* G = WSP<bf16_t>(p, KIND ? ML_G : GQ_G);
  bf16_t* O = WSP<bf16_t>(p, OFF_HB);
  const int tid = TIDX, lane = tid & 63, w = __builtin_amdgcn_readfirstlane(tid >> 6), r16 = lane & 15, kq = lane >> 4;
  const int fsw = (r16 >> 1) & 7;
  const int n_lat = KIND ? NB * 8 * (S / 256) : NB * 4 * (S / 64);
  const int n_ctx = with_ctx ? (KIND ? NB * 8 : NB * 4 * 4) : 0;
  for (int item = vblock(); item < n_lat + n_ctx; item += gridDim.x) {
    const bool isc = item >= n_lat;
    int b, kvh, q0, nw = 0, wrow0 = 0, qs = 0, lo = 0;
    if (!isc) {
      if (KIND) { const int qb = item % 32; kvh = (item / 32) % 8; b = item / 256; q0 = b * S + qb * 256; nw = 128; wrow0 = b * S; }
      else { const int qb = item % 128; kvh = (item / 128) % 4; b = item / 512; qs = qb * 64; lo = qs - 128 < 0 ? 0 : qs - 128; const int hi = qs + 192 > S ? S : qs + 192; nw = (hi - lo) / 64; wrow0 = b * S + lo; q0 = b * S + qs; }
    } else {
      const int j = item - n_lat;
      if (KIND) { kvh = j % 8; b = j / 8; q0 = NLAT + b * L; }
      else { const int qb = j % 4; kvh = (j / 4) % 4; b = j / 16; q0 = NLAT + b * L + qb * 64; }
    }
    const int ntl = nw + 4, crow0 = NLAT + b * L;
    const int head = KIND ? kvh : kvh * 4 + (w & 3);
    const int qrow0 = (KIND ? q0 + w * 32 : q0 + (w >> 2) * 32) + r16;
    const int qp0 = qs + (w >> 2) * 32 + r16;
    bf16x8 qf[2][NKS];
#pragma unroll
    for (int qt = 0; qt < 2; ++qt)
#pragma unroll
      for (int ks = 0; ks < NKS; ++ks) qf[qt][ks] = *(const bf16x8*)(Qb + (size_t)(qrow0 + 16 * qt) * LDQ + head * DQK + ks * 32 + kq * 8);
#pragma unroll
    for (int qt = 0; qt < 2; ++qt)
#pragma unroll
      for (int ks = 0; ks < NKS; ++ks) asm volatile("" :: "v"(qf[qt][ks]));
    float m[2], l[2];
    f32x4 o[2][NDT];
#pragma unroll
    for (int qt = 0; qt < 2; ++qt) {
      m[qt] = KIND ? -1e30f : sink[head] * LOG2E; l[qt] = KIND ? 0.f : 1.f;
#pragma unroll
      for (int i = 0; i < NDT; ++i)
#pragma unroll
        for (int e = 0; e < 4; ++e) o[qt][i][e] = 0.f;
    }
    unsigned gk[NKC], gv[NVC];
#pragma unroll
    for (int i = 0; i < NKC; ++i) { const int q = (w + 8 * i) * 64 + lane, row = q / KCPR, cp = q % KCPR; gk[i] = (unsigned)(row * LDK + kvh * DQK + ((cp ^ ((row >> 1) & 7)) << 3)); }
#pragma unroll
    for (int i = 0; i < NVC; ++i) { const int row = 8 * (w + 8 * i) + (lane >> 3), cp = lane & 7;
      const int prow = (row & ~31) | (((row >> 2) & 3) << 3) | (((row >> 4) & 1) << 2) | (row & 3);
      gv[i] = (unsigned)((kvh * DV + prow) * NT + ((cp ^ ((row >> 1) & 7)) << 3)); }
#define A_ISSUE(t, buf) do { const int key0_ = (t) < nw ? wrow0 + 64 * (t) : crow0 + 64 * ((t) - nw); char* st_ = smem + (buf) * STAGE; \
      const bf16_t* kb_ = Kb + (size_t)key0_ * LDK; const bf16_t* vb_ = Vt + key0_; \
      _Pragma("unroll") for (int i = 0; i < NKC; ++i) GLDS16(kb_ + gk[i], st_ + (w + 8 * i) * 1024); \
      _Pragma("unroll") for (int i = 0; i < NVC; ++i) GLDS16(vb_ + gv[i], st_ + KS_BYTES + (w + 8 * i) * 1024); } while (0)
    A_ISSUE(0, 0); A_ISSUE(1, 1);
    int buf = 0;
#pragma clang loop unroll(disable)
    for (int t = 0; t < ntl; ++t) {
      if (t + 1 < ntl) { if (NKC + NVC == 5) WAIT_VM(5); else WAIT_VM(2); } else WAIT_VM(0);
      RAW_BARRIER();
      if (t + 2 < ntl) { const int nb = buf >= 1 ? buf - 1 : 2; A_ISSUE(t + 2, nb); }
      const char* Ks = smem + buf * STAGE + r16 * KROW; const char* Vs = smem + buf * STAGE + KS_BYTES + r16 * VROW;
      buf = buf == 2 ? 0 : buf + 1;
      f32x4 s[2][4];
#pragma unroll
      for (int qt = 0; qt < 2; ++qt)
#pragma unroll
        for (int kt = 0; kt < 4; ++kt)
#pragma unroll
          for (int e = 0; e < 4; ++e) s[qt][kt][e] = 0.f;
      {
        bf16x8 a[4], an[4];
#pragma unroll
        for (int kt = 0; kt < 4; ++kt) a[kt] = *(const bf16x8*)(Ks + kt * 16 * KROW + ((kq ^ fsw) << 4));
#pragma unroll
        for (int ks = 0; ks < NKS; ++ks) {
          if (ks + 1 < NKS) {
            const int kco = ((4 * (ks + 1) + kq) ^ fsw) << 4;
#pragma unroll
            for (int kt = 0; kt < 4; ++kt) an[kt] = *(const bf16x8*)(Ks + kt * 16 * KROW + kco);
          }
#pragma unroll
          for (int kt = 0; kt < 4; ++kt)
#pragma unroll
            for (int qt = 0; qt < 2; ++qt) s[qt][kt] = MFMA16(a[kt], qf[qt][ks], s[qt][kt]);
#pragma unroll
          for (int kt = 0; kt < 4; ++kt) a[kt] = an[kt];
        }
      }
      bf16x8 pf[2][2];
      const int wq_lo = qs + (w >> 2) * 32, tk_lo = lo + 64 * t;
      const bool need_mask = (tk_lo + 63 - wq_lo > 128) || (wq_lo + 31 - tk_lo > 128);
#pragma unroll
      for (int qt = 0; qt < 2; ++qt) {
        if (KIND == 0 && !isc && t < nw && need_mask) {
          const int kb0 = lo + 64 * t + 4 * kq, qp = qp0 + 16 * qt;
#pragma unroll
          for (int kt = 0; kt < 4; ++kt)
#pragma unroll
            for (int e = 0; e < 4; ++e) { int d0 = kb0 + 16 * kt + e - qp; d0 = d0 < 0 ? -d0 : d0; if (d0 > 128) s[qt][kt][e] = -1e30f; }
        }
        float tmax = s[qt][0][0];
#pragma unroll
        for (int kt = 0; kt < 4; ++kt)
#pragma unroll
          for (int e = 0; e < 4; ++e) tmax = fmaxf(tmax, s[qt][kt][e]);
        tmax = fmaxf(tmax, __shfl_xor(tmax, 16)); tmax = fmaxf(tmax, __shfl_xor(tmax, 32));
        const float mn = fmaxf(m[qt], tmax);
        const bool resc = __any(mn > m[qt]);
        const float alpha = resc ? __builtin_amdgcn_exp2f(m[qt] - mn) : 1.f;
        m[qt] = mn;
        const f32x4 mn4 = {mn, mn, mn, mn};
        f32x4 rs4 = {0.f, 0.f, 0.f, 0.f};
#pragma unroll
        for (int kt = 0; kt < 4; ++kt) {
          const f32x4 d = s[qt][kt] - mn4;
#pragma unroll
          for (int e = 0; e < 4; ++e) s[qt][kt][e] = __builtin_amdgcn_exp2f(d[e]);
          rs4 += s[qt][kt];
        }
        float rsum = (rs4[0] + rs4[1]) + (rs4[2] + rs4[3]);
        rsum += __shfl_xor(rsum, 16); rsum += __shfl_xor(rsum, 32);
        l[qt] = l[qt] * alpha + rsum;
        if (resc) {
#pragma unroll
          for (int i = 0; i < NDT; ++i)
#pragma unroll
            for (int e = 0; e < 4; ++e) o[qt][i][e] *= alpha;
        }
#pragma unroll
        for (int st = 0; st < 2; ++st) {
          u32x4 u = {pack2(s[qt][2 * st][0], s[qt][2 * st][1]), pack2(s[qt][2 * st][2], s[qt][2 * st][3]), pack2(s[qt][2 * st + 1][0], s[qt][2 * st + 1][1]), pack2(s[qt][2 * st + 1][2], s[qt][2 * st + 1][3])};
          pf[qt][st] = __builtin_bit_cast(bf16x8, u);
        }
      }
      {
        bf16x8 vc[2], vn[2];
#pragma unroll
        for (int st = 0; st < 2; ++st) vc[st] = *(const bf16x8*)(Vs + (((4 * st + kq) ^ fsw) << 4));
#pragma unroll
        for (int dt = 0; dt < NDT; ++dt) {
          if (dt + 1 < NDT) {
#pragma unroll
            for (int st = 0; st < 2; ++st) vn[st] = *(const bf16x8*)(Vs + (dt + 1) * 16 * VROW + (((4 * st + kq) ^ fsw) << 4));
          }
#pragma unroll
          for (int st = 0; st < 2; ++st)
#pragma unroll
            for (int qt = 0; qt < 2; ++qt) o[qt][dt] = MFMA16(vc[st], pf[qt][st], o[qt][dt]);
#pragma unroll
          for (int st = 0; st < 2; ++st) vc[st] = vn[st];
        }
      }
    }
    RAW_BARRIER();
#pragma unroll
    for (int qt = 0; qt < 2; ++qt) {
      const float inv = 1.f / l[qt];
#pragma unroll
      for (int dp = 0; dp < NDT / 2; ++dp) {
        const size_t oi = (size_t)(qrow0 + 16 * qt) * 1024 + head * DV + dp * 32 + 8 * kq;
        const uint4 g8 = *(const uint4*)(G + oi);
        float gf[8]; unpack8(g8, gf);
        u32x4_t wv = {pack2rne(o[qt][2 * dp][0] * inv * gf[0], o[qt][2 * dp][1] * inv * gf[1]), pack2rne(o[qt][2 * dp][2] * inv * gf[2], o[qt][2 * dp][3] * inv * gf[3]),
                      pack2rne(o[qt][2 * dp + 1][0] * inv * gf[4], o[qt][2 * dp + 1][1] * inv * gf[5]), pack2rne(o[qt][2 * dp + 1][2] * inv * gf[6], o[qt][2 * dp + 1][3] * inv * gf[7])};
        *(u32x4_t*)(O + oi) = wv;
      }
    }
  }
}

constexpr int LKR = 272;
DI void phase_lstm_scan(const P& p, char* smem) {
  const bf16_t* QK = WSP<bf16_t>(p, OFF_HB); const bf16_t* Vt = WSP<bf16_t>(p, LS_VT);
  const float *EE = WSP<float>(p, LS_EE), *TOT = WSP<float>(p, LS_TOT), *MLOC = WSP<float>(p, LS_MLOC);
  float *MST = WSP<float>(p, LS_MST), *NST = WSP<float>(p, LS_NST); bf16_t* CST = WSP<bf16_t>(p, LS_CST);
  const int tid = TIDX, lane = tid & 63, w = tid >> 6, r = lane & 31, h = lane >> 5;
  const int srow = tid >> 4, scc = tid & 15;
  for (int item = blockIdx.x; item < 256; item += gridDim.x) {
    const int vs = item & 7, dir = (item >> 3) & 1, hd = (item >> 4) & 3, b = item >> 6, bhd = (b * 4 + hd) * 2 + dir;
    f32x16 C;
#pragma unroll
    for (int e = 0; e < 16; ++e) C[e] = 0.f;
    float nst = 0.f, m = -1e30f;
    u32x4 k0, k1, k2, k3; float e0, e1, e2, e3;
#define S_LOAD(c) do { const int base_ = chunk_base(b, dir, (c)); const bf16_t* kp_ = QK + (size_t)(base_ + srow) * 1024 + 512 + hd * 128 + scc * 8; const float* ep_ = EE + ((size_t)dir * 4 + hd) * NT + base_ + srow; \
      k0 = *(const u32x4*)(kp_); k1 = *(const u32x4*)(kp_ + 32 * 1024); k2 = *(const u32x4*)(kp_ + 64 * 1024); k3 = *(const u32x4*)(kp_ + 96 * 1024); e0 = ep_[0]; e1 = ep_[32]; e2 = ep_[64]; e3 = ep_[96]; } while (0)
#define S_SCALE(kv, sc) ({ u32x4 o_; _Pragma("unroll") for (int q_ = 0; q_ < 4; ++q_) { const unsigned u_ = (kv)[q_]; o_[q_] = pack2(__uint_as_float(u_ << 16) * (sc), __uint_as_float(u_ & 0xffff0000u) * (sc)); } o_; })
    S_LOAD(0);
    for (int c = 0; c < NCH; ++c) {
      const int it = bhd * NCH + c, base = chunk_base(b, dir, c);
      const float tot = TOT[it], ml = MLOC[it], mn = fmaxf(tot + m, ml), a = __expf(tot + m - mn), bb = __expf(ml - mn);
      char* Ks = smem + (c & 1) * (128 * LKR);
      { char* d_ = Ks + srow * LKR + scc * 16;
        *(u32x4*)(d_) = S_SCALE(k0, bb * e0); *(u32x4*)(d_ + 32 * LKR) = S_SCALE(k1, bb * e1); *(u32x4*)(d_ + 64 * LKR) = S_SCALE(k2, bb * e2); *(u32x4*)(d_ + 96 * LKR) = S_SCALE(k3, bb * e3); }
      bf16x8 vf[8];
      if (w < 4) {
        const bf16_t* vp = Vt + (size_t)(hd * 256 + vs * 32 + r) * NT + base + 8 * h;
#pragma unroll
        for (int g = 0; g < 8; ++g) vf[g] = *(const bf16x8*)(vp + 16 * g);
      }
      __syncthreads();
      if (c + 1 < NCH) S_LOAD(c + 1);
      if (w < 4) {
        bf16_t* cp = CST + ((size_t)it * 256 + vs * 32 + r) * 128 + 32 * w + 4 * h;
#pragma unroll
        for (int g = 0; g < 4; ++g) { ushort4 o; o.x = f2bf(C[4 * g]); o.y = f2bf(C[4 * g + 1]); o.z = f2bf(C[4 * g + 2]); o.w = f2bf(C[4 * g + 3]); *(ushort4*)(cp + 8 * g) = o; }
#pragma unroll
        for (int e = 0; e < 16; ++e) C[e] *= a;
#pragma unroll
        for (int g = 0; g < 8; ++g) {
          bf16x8 kf;
#pragma unroll
          for (int j = 0; j < 8; ++j) { const int tok = 16 * g + 8 * (j >> 2) + 4 * h + (j & 3); kf[j] = *(const short*)(Ks + tok * LKR + (32 * w + r) * 2); }
          C = MFMA(kf, vf[g], C);
        }
      } else if (w < 6) {
        const int k = tid - 256;
        if (vs == 0) NST[(size_t)it * 128 + k] = nst;
        float sum = 0.f;
#pragma unroll 8
        for (int t = 0; t < 128; ++t) sum += bf2f(*(const bf16_t*)(Ks + t * LKR + k * 2));
        nst = a * nst + sum;
      }
      if (vs == 0 && tid == 0) MST[it] = m;
      m = mn;
    }
    __syncthreads();
  }
}

DI void phase_lstm_out(const P& p, char* smem) {
  const bf16_t* QK = WSP<bf16_t>(p, OFF_HB); const bf16_t* Vt = WSP<bf16_t>(p, LS_VT);
  const float *CUM = WSP<float>(p, LS_CUM), *PM = WSP<float>(p, LS_PM), *BV = WSP<float>(p, LS_BV);
  const float *MST = WSP<float>(p, LS_MST), *NST = WSP<float>(p, LS_NST); const bf16_t* CST = WSP<bf16_t>(p, LS_CST);
  bf16_t* OB = WSP<bf16_t>(p, LS_OB); const bf16_t* G = WSP<bf16_t>(p, LS_G);
  char* Ks = smem; char* Vs = smem + 128 * LKR;
  float* bvs = (float*)(smem + 384 * LKR); float* nss = bvs + 256; float* red = nss + 256;
  static_assert(384 * LKR + 3 * 1024 <= SMEM_BYTES, "lstm out lds");
  const int tid = TIDX, lane = tid & 63, w = tid >> 6, r = lane & 31, h = lane >> 5;
  const int tt = w & 3, vh = w >> 2;
  for (int item = blockIdx.x; item < NB * 4 * NCH; item += gridDim.x) {
    const int mb = item % NCH, hd = (item / NCH) & 3, b = item / (NCH * 4);
    const int base = mb < 2 ? NLAT + b * L + mb * 128 : b * S + (mb - 2) * 128;
    {
      const int srow = tid >> 4, scc = tid & 15;
      u32x4 kst[4], vst[8];
#pragma unroll
      for (int i = 0; i < 4; ++i) kst[i] = *(const u32x4*)(QK + (size_t)(base + srow + 32 * i) * 1024 + 512 + hd * 128 + scc * 8);
#pragma unroll
      for (int i = 0; i < 8; ++i) vst[i] = *(const u32x4*)(Vt + (size_t)(hd * 256 + srow + 32 * i) * NT + base + scc * 8);
#pragma unroll
      for (int i = 0; i < 4; ++i) *(u32x4*)(Ks + (srow + 32 * i) * LKR + scc * 16) = kst[i];
#pragma unroll
      for (int i = 0; i < 8; ++i) *(u32x4*)(Vs + (srow + 32 * i) * LKR + scc * 16) = vst[i];
    }
    int its[2];
#pragma unroll
    for (int dir = 0; dir < 2; ++dir) { const int c = mb < 2 ? (dir ? 1 - mb : mb) : 2 + (dir ? 63 - (mb - 2) : mb - 2); its[dir] = ((b * 4 + hd) * 2 + dir) * NCH + c; }
    if (tid < 256) {
      const int dir = tid >> 7, i = tid & 127; bvs[tid] = BV[((size_t)dir * 4 + hd) * NT + base + i];
      const float* ns = NST + (size_t)(dir ? its[1] : its[0]) * 128; const bf16_t* qp = QK + (size_t)(base + i) * 1024 + hd * 128; float s_ = 0.f;
      for (int k = 0; k < 128; k += 8) { float qv[8]; unpack8(*(const uint4*)(qp + k), qv); const float4 n0 = *(const float4*)(ns + k), n1 = *(const float4*)(ns + k + 4);
        s_ += qv[0] * n0.x + qv[1] * n0.y + qv[2] * n0.z + qv[3] * n0.w + qv[4] * n1.x + qv[5] * n1.y + qv[6] * n1.z + qv[7] * n1.w; }
      nss[tid] = s_;
    }
    const int trow = base + tt * 32 + r;
    float mstv[2], pmv[2], cumv[2];
#pragma unroll
    for (int dir = 0; dir < 2; ++dir) { const size_t po = ((size_t)dir * 4 + hd) * NT + trow; mstv[dir] = MST[its[dir]]; pmv[dir] = PM[po]; cumv[dir] = CUM[po]; }
    bf16x8 qf[8];
#pragma unroll
    for (int ks = 0; ks < 8; ++ks) qf[ks] = *(const bf16x8*)(QK + (size_t)trow * 1024 + hd * 128 + ks * 16 + h * 8);
    __syncthreads();
    f32x16 hs[4];
#pragma unroll
    for (int i = 0; i < 4; ++i)
#pragma unroll
      for (int e = 0; e < 16; ++e) hs[i][e] = 0.f;
#pragma unroll 1
    for (int dir = 0; dir < 2; ++dir) {
      const int itd = dir ? its[1] : its[0];
      const float mst = dir ? mstv[1] : mstv[0], pmx = dir ? pmv[1] : pmv[0], cmx = dir ? cumv[1] : cumv[0];
      const float mx = fmaxf(mst, pmx), at = __expf(mst - mx), fl = __expf(-cmx - mx);
      const float nq = nss[dir * 128 + tt * 32 + r];
      float den = at * nq;
      const int st_lo = dir ? tt : 0, st_hi = dir ? 3 : tt;
      for (int st = st_lo; st <= st_hi; ++st) {
        f32x16 sc;
#pragma unroll
        for (int e = 0; e < 16; ++e) sc[e] = 0.f;
#pragma unroll
        for (int ks = 0; ks < 8; ++ks) { const bf16x8 kf = *(const bf16x8*)(Ks + (st * 32 + r) * LKR + ks * 32 + h * 16); sc = MFMA(kf, qf[ks], sc); }
        float ps = 0.f;
#pragma unroll
        for (int e = 0; e < 16; ++e) {
          const int sl = (e & 3) + 8 * (e >> 2) + 4 * h;
          float wgt = __expf(bvs[dir * 128 + st * 32 + sl] - mx);
          if (st == tt && (dir ? sl < r : sl > r)) wgt = 0.f;
          ps += sc[e] * wgt;
        }
        den += ps + __shfl_xor(ps, 32);
      }
      const float dinv = 1.f / fmaxf(fabsf(den), fl);
      {
        const float sq = at * dinv;
        const bf16_t* cp = CST + ((size_t)itd * 256 + vh * 128 + r) * 128 + 8 * h;
#pragma unroll
        for (int vt = 0; vt < 4; ++vt) {
          bf16x8 cf[8];
#pragma unroll
          for (int ks = 0; ks < 8; ++ks) cf[ks] = *(const bf16x8*)(cp + (size_t)vt * 32 * 128 + ks * 16);
          f32x16 ta;
#pragma unroll
          for (int e = 0; e < 16; ++e) ta[e] = 0.f;
#pragma unroll
          for (int ks = 0; ks < 8; ++ks) ta = MFMA(cf[ks], qf[ks], ta);
#pragma unroll
          for (int e = 0; e < 16; ++e) hs[vt][e] += sq * ta[e];
        }
      }
      for (int st = st_lo; st <= st_hi; ++st) {
        f32x16 sc;
#pragma unroll
        for (int e = 0; e < 16; ++e) sc[e] = 0.f;
#pragma unroll
        for (int ks = 0; ks < 8; ++ks) { const bf16x8 kf = *(const bf16x8*)(Ks + (st * 32 + r) * LKR + ks * 32 + h * 16); sc = MFMA(kf, qf[ks], sc); }
#pragma unroll
        for (int e = 0; e < 16; ++e) {
          const int sl = (e & 3) + 8 * (e >> 2) + 4 * h;
          float wgt = __expf(bvs[dir * 128 + st * 32 + sl] - mx) * dinv;
          if (st == tt && (dir ? sl < r : sl > r)) wgt = 0.f;
          sc[e] *= wgt;
        }
        bf16x8 pf[2];
#pragma unroll
        for (int s2 = 0; s2 < 2; ++s2) { u32x4 u = {pack2(sc[8 * s2], sc[8 * s2 + 1]), pack2(sc[8 * s2 + 2], sc[8 * s2 + 3]), pack2(sc[8 * s2 + 4], sc[8 * s2 + 5]), pack2(sc[8 * s2 + 6], sc[8 * s2 + 7])}; pf[s2] = __builtin_bit_cast(bf16x8, u); }
#pragma unroll
        for (int vt = 0; vt < 4; ++vt)
#pragma unroll
          for (int s2 = 0; s2 < 2; ++s2) { const bf16x8 vf = *(const bf16x8*)(Vs + (vh * 128 + vt * 32 + r) * LKR + (st * 32 + s2 * 16) * 2 + h * 16); hs[vt] = MFMA(vf, pf[s2], hs[vt]); }
      }
    }
    const size_t ob0 = (size_t)trow * 1024 + hd * 256 + vh * 128 + 4 * h;
    ushort4 obv[16];
#pragma unroll
    for (int q = 0; q < 16; ++q) obv[q] = *(const ushort4*)(OB + ob0 + (q >> 2) * 32 + (q & 3) * 8);
    float ss = 0.f;
#pragma unroll
    for (int vt = 0; vt < 4; ++vt)
#pragma unroll
      for (int g = 0; g < 4; ++g) {
        const ushort4 ov = obv[vt * 4 + g];
        hs[vt][4 * g] *= bf2f(ov.x); hs[vt][4 * g + 1] *= bf2f(ov.y); hs[vt][4 * g + 2] *= bf2f(ov.z); hs[vt][4 * g + 3] *= bf2f(ov.w);
        ss += hs[vt][4 * g] * hs[vt][4 * g] + hs[vt][4 * g + 1] * hs[vt][4 * g + 1] + hs[vt][4 * g + 2] * hs[vt][4 * g + 2] + hs[vt][4 * g + 3] * hs[vt][4 * g + 3];
      }
    ss += __shfl_xor(ss, 32);
    if (h == 0) red[vh * 128 + tt * 32 + r] = ss;
    ushort4 gvv[16];
#pragma unroll
    for (int q = 0; q < 16; ++q) gvv[q] = *(const ushort4*)(G + ob0 + (q >> 2) * 32 + (q & 3) * 8);
    __syncthreads();
    const float rs = rsqrtf((red[tt * 32 + r] + red[128 + tt * 32 + r]) * (1.f / 256) + EPS);
    const float* ghp = p.g_head + hd * 256 + vh * 128 + 4 * h;
#pragma unroll
    for (int vt = 0; vt < 4; ++vt) {
      float4 ghv[4];
#pragma unroll
      for (int g = 0; g < 4; ++g) ghv[g] = *(const float4*)(ghp + vt * 32 + g * 8);
#pragma unroll
      for (int g = 0; g < 4; ++g) {
        const ushort4 gv = gvv[vt * 4 + g]; const float4 gh = ghv[g];
        float v[4] = {hs[vt][4 * g] * rs * gh.x * bf2f(gv.x), hs[vt][4 * g + 1] * rs * gh.y * bf2f(gv.y), hs[vt][4 * g + 2] * rs * gh.z * bf2f(gv.z), hs[vt][4 * g + 3] * rs * gh.w * bf2f(gv.w)};
        st4(OB + ob0 + vt * 32 + g * 8, v);
      }
    }
    __syncthreads();
  }
}
__global__ __launch_bounds__(512) void k_lstm_scan(P p) { __shared__ __attribute__((aligned(16))) char smem[SMEM_BYTES]; phase_lstm_scan(p, smem); }
__global__ __launch_bounds__(512) void k_lstm_out(P p) { __shared__ __attribute__((aligned(16))) char smem[SMEM_BYTES]; phase_lstm_out(p, smem); }

#define XB_TMO      128
#define XB_XCNT(j)  (256  + 64 * (j))
#define XB_XSUB(j)  (1280 + 64 * (j))
#define XB_XGEN(j)  (2304 + 64 * (j))
#define XB_TOP      3328
#define XB_TOPGEN   3392
#define XCD_BAR_WORDS 3456
#define XB_SPIN_CAP (1u << 18)
#define LAS __attribute__((address_space(3)))

__device__ __forceinline__ unsigned xb_ld(unsigned* p)              { return __hip_atomic_load(p, __ATOMIC_RELAXED, __HIP_MEMORY_SCOPE_AGENT); }
__device__ __forceinline__ unsigned xb_add(unsigned* p, unsigned v) { return __hip_atomic_fetch_add(p, v, __ATOMIC_RELAXED, __HIP_MEMORY_SCOPE_AGENT); }
__device__ __forceinline__ unsigned xb_xcc_id() { return (unsigned)__builtin_amdgcn_s_getreg((3 << 11) | 20) & 0xFu; }
#define XB_SPIN(cond, bar) do { unsigned _sp = 0; while (cond) { __builtin_amdgcn_s_sleep(1); \
    if ((++_sp & 255u) == 0u) { if (xb_ld(&(bar)[XB_TMO])) break; if (_sp > XB_SPIN_CAP) { atomicAdd(&(bar)[XB_TMO], 1u); break; } } } } while (0)

struct XcdBarrier {
    unsigned* bar; unsigned x;
    volatile LAS unsigned* st;
};

__device__ __forceinline__ XcdBarrier xcd_barrier_post(unsigned* bar, volatile LAS unsigned* st) {
    XcdBarrier b; b.bar = bar; b.x = xb_xcc_id(); b.st = st;
    if (TIDX == 0) (void)xb_add(&bar[XB_XCNT(b.x)], 1u);
    return b;
}
__device__ __forceinline__ void xcd_barrier_complete(unsigned* bar, unsigned x, unsigned& nloc, unsigned& nx) {
    const unsigned G = gridDim.x * gridDim.y * gridDim.z;
    unsigned sum, cnt, mine, sp = 0u;
    for (;;) {
        sum = 0u; cnt = 0u; mine = 0u;
#pragma unroll
        for (unsigned j = 0; j < 16; ++j) { const unsigned c = xb_ld(&bar[XB_XCNT(j)]); sum += c; cnt += (c > 0u) ? 1u : 0u; mine = (j == x) ? c : mine; }
        if (sum == G) break;
        __builtin_amdgcn_s_sleep(1);
        if ((++sp & 255u) == 0u) { if (xb_ld(&bar[XB_TMO])) break; if (sp > XB_SPIN_CAP) { atomicAdd(&bar[XB_TMO], 1u); break; } }
    }
    nloc = mine > 0u ? mine : 1u; nx = cnt > 0u ? cnt : 1u;
}

__device__ __forceinline__ void xcd_barrier(const XcdBarrier& b) {
    asm volatile("s_waitcnt vmcnt(0)" ::: "memory");
    __syncthreads();
    if (TIDX == 0) {
        unsigned* bar = b.bar;
        __builtin_amdgcn_s_waitcnt(0);
        unsigned nloc = b.st[0], nx = b.st[1];
        if (nloc == 0u) { xcd_barrier_complete(bar, b.x, nloc, nx); b.st[0] = nloc; b.st[1] = nx; }
        const unsigned old = xb_add(&bar[XB_XSUB(b.x)], 1u);
        const unsigned gen = old / nloc;
        if (old + 1u == (gen + 1u) * nloc) {
            __builtin_amdgcn_fence(__ATOMIC_RELEASE, "agent");
            asm volatile("s_waitcnt vmcnt(0)" ::: "memory");
            const unsigned og = xb_add(&bar[XB_TOP], 1u);
            const unsigned tg = og / nx;
            if (og + 1u == (tg + 1u) * nx) xb_add(&bar[XB_TOPGEN], 1u);
            else XB_SPIN(xb_ld(&bar[XB_TOPGEN]) == tg, bar);
            __builtin_amdgcn_fence(__ATOMIC_ACQUIRE, "agent");
            xb_add(&bar[XB_XGEN(b.x)], 1u);
            asm volatile("s_waitcnt vmcnt(0)" ::: "memory");
        } else {
            XB_SPIN(xb_ld(&bar[XB_XGEN(b.x)]) == gen, bar);
            __builtin_amdgcn_fence(__ATOMIC_ACQUIRE, "agent");
            asm volatile("s_waitcnt vmcnt(0)" ::: "memory");
        }
    }
    __syncthreads();
}


namespace cg = cooperative_groups;
#ifndef REP_MLA
#define REP_MLA 1
#endif
#ifndef REP_GEMM
#define REP_GEMM 1
#endif
#ifndef REP_GOUT
#define REP_GOUT 1
#endif
#ifndef REP_GSM
#define REP_GSM 1
#endif
#ifndef REP_PRO
#define REP_PRO 1
#endif
#ifndef REP_CONV
#define REP_CONV 1
#endif
#ifndef REP_ROW0
#define REP_ROW0 1
#endif
#ifndef REP_SYNC
#define REP_SYNC 1
#endif
#ifndef REP_GQA
#define REP_GQA 1
#endif
#ifndef REP_LSTM
#define REP_LSTM 1
#endif
#define REPEAT(n) for (int rep_ = 0; rep_ < (n); ++rep_)
__global__ __launch_bounds__(512) void k_mega(P p) {
  __shared__ __attribute__((aligned(16))) char smem[SMEM_BYTES];
  cg::grid_group grid = cg::this_grid();
  __shared__ uint4 xb_words;
  if (TIDX == 0) xb_words = make_uint4(0u, 0u, 0u, 0u);
  __syncthreads();
  const XcdBarrier xb = xcd_barrier_post(WSP<unsigned>(p, OFF_BAR), (volatile LAS unsigned*)&xb_words);
  bf16_t* HB = WSP<bf16_t>(p, OFF_HB);
  REPEAT(REP_PRO) phase_prologue(p, smem); if (p.ws == nullptr) grid.sync(); xcd_barrier(xb);
  REPEAT(REP_ROW0) phase_rowwise(p, 0, nullptr); xcd_barrier(xb);
  REPEAT(REP_GEMM) phase_gemm<M_IN_GQA, false>(p, HB, 1024, WINT(p, 0), 1024, 2560, NT, nullptr, smem); xcd_barrier(xb);
  REPEAT(REP_GQA) phase_attn<0>(p, p.sink[0], true, smem); xcd_barrier(xb);
  REPEAT(REP_GOUT) phase_gemm<M_OUT, false>(p, HB, 1024, WOUTT(p, 0), 1024, 1024, NT, WSP<bf16_t>(p, GQ_Y), smem); xcd_barrier(xb);
  phase_rowwise(p, 1, WSP<bf16_t>(p, GQ_Y)); xcd_barrier(xb);
  REPEAT(REP_GEMM) phase_gemm<M_IN_MLA, false>(p, HB, 1024, WINT(p, 1), 1024, 1472, NT, nullptr, smem); xcd_barrier(xb);
  REPEAT(REP_GSM) phase_gemm<M_UQ, true>(p, WSP<bf16_t>(p, ML_QA), 256, WSP<bf16_t>(p, OFF_WUQ), 256, 1536, NT, nullptr, smem);
  REPEAT(REP_GSM) phase_gemm<M_UKV, true>(p, WSP<bf16_t>(p, ML_KVA), 128, WSP<bf16_t>(p, OFF_WUKV), 128, 2048, NT, nullptr, smem); xcd_barrier(xb);
  REPEAT(REP_MLA) phase_attn<1>(p, nullptr, true, smem); xcd_barrier(xb);
  REPEAT(REP_GOUT) phase_gemm<M_OUT, false>(p, HB, 1024, WOUTT(p, 1), 1024, 1024, NT, WSP<bf16_t>(p, ML_Y), smem); xcd_barrier(xb);
  phase_rowwise(p, 2, WSP<bf16_t>(p, ML_Y)); xcd_barrier(xb);
  REPEAT(REP_GEMM) phase_gemm<M_IN_LSTM, false>(p, HB, 1024, WINT(p, 2), 1024, 4112, NT, nullptr, smem); xcd_barrier(xb);
  REPEAT(REP_CONV) { phase_conv(p); phase_prep(p); } xcd_barrier(xb);
  REPEAT(REP_LSTM) phase_lstm_scan(p, smem); xcd_barrier(xb);
  phase_lstm_out(p, smem); xcd_barrier(xb);
  REPEAT(REP_GOUT) phase_gemm<M_OUT, false>(p, WSP<bf16_t>(p, LS_OB), 1024, WOUTT(p, 2), 1024, 1024, NT, WSP<bf16_t>(p, LS_Y), smem); xcd_barrier(xb);
  phase_rowwise(p, 3, WSP<bf16_t>(p, LS_Y)); xcd_barrier(xb);
  REPEAT(REP_GEMM) phase_gemm<M_IN_GQA, false>(p, HB, 1024, WINT(p, 3), 1024, 2560, NT, nullptr, smem); xcd_barrier(xb);
  REPEAT(REP_GQA) phase_attn<0>(p, p.sink[3], false, smem); xcd_barrier(xb);
  REPEAT(REP_GOUT) phase_gemm<M_OUT, false>(p, HB, 1024, WOUTT(p, 3), 1024, 1024, NLAT, WSP<bf16_t>(p, GQ_Y), smem); xcd_barrier(xb);
  phase_rowwise(p, 4, WSP<bf16_t>(p, GQ_Y));
}

template <int MODE, bool ROWSCALE>
__global__ __launch_bounds__(512) void k_gemm(P p, const bf16_t* A, int lda, const bf16_t* Wt, int K, int N, int M, bf16_t* Y) {
  __shared__ __attribute__((aligned(16))) char smem[SMEM_BYTES]; phase_gemm<MODE, ROWSCALE>(p, A, lda, Wt, K, N, M, Y, smem);
}
template <int KIND>
__global__ __launch_bounds__(512) void k_attn(P p, const float* sink, int with_ctx) {
  __shared__ __attribute__((aligned(16))) char smem[SMEM_BYTES]; phase_attn<KIND>(p, sink, with_ctx != 0, smem);
}

__global__ __launch_bounds__(256) void k_prologue(P p) { __shared__ __attribute__((aligned(16))) char smem[64 * 68 * 4]; phase_prologue(p, smem); }
__global__ __launch_bounds__(256) void k_rowwise(P p, int l, const bf16_t* Y) { phase_rowwise(p, l, Y); }
__global__ __launch_bounds__(256) void k_conv(P p) { phase_conv(p); }
__global__ __launch_bounds__(256) void k_prep(P p) { phase_prep(p); }


#ifndef MEGA
#define MEGA 1
#endif
#ifndef FAST_LSTM
#define FAST_LSTM 1
#endif
#ifndef FAST_GEMM
#define FAST_GEMM 1
#endif
#ifndef FAST_ATTN
#define FAST_ATTN 1
#endif
#if FAST_GEMM
#define GEMM_L(MODE, RS) k_gemm<MODE, RS><<<256, 512, 0, stream>>>
#else
#define GEMM_L(MODE, RS) k_gemm_naive<MODE, RS><<<G * 4, 256, 0, stream>>>
#endif
#if FAST_ATTN
#define ATTN0_L(l) k_attn<0><<<256, 512, 0, stream>>>(p, p.sink[l], l == 0 ? 1 : 0)
#define ATTN1_L() k_attn<1><<<256, 512, 0, stream>>>(p, nullptr, 1)
#else
#define ATTN0_L(l) k_attn_naive<0><<<G * 4, 256, 0, stream>>>(p, p.sink[l], 0, Mout)
#define ATTN1_L() k_attn_naive<1><<<G * 4, 256, 0, stream>>>(p, nullptr, 0, NT)
#endif

extern "C" void kernel_launch(void* const* d_in, const int* in_sizes, int n_in, void* d_out, int out_size, void* d_ws, size_t ws_size, hipStream_t stream) {
  if (n_in != 37 || ws_size < WS_NEED) { fprintf(stderr, "kernel_launch: bad n_in %d or ws %zu < %zu\n", n_in, ws_size, (size_t)WS_NEED); return; }
  P p{};
  auto F = [&](int i) { return (const float*)d_in[i]; };
  p.x = F(0); p.c = F(1); p.ctx = F(2); p.cctx = F(3);
  const int base[4] = {4, 11, 21, 30};
  for (int l = 0; l < 4; ++l) { p.w_ada[l] = F(base[l]); p.b_ada[l] = F(base[l] + 1); p.g_pre[l] = F(base[l] + 2); p.g_post[l] = F(base[l] + 3); p.w_in[l] = F(base[l] + 4); p.sink[l] = nullptr; }
  p.sink[0] = F(9); p.w_out[0] = F(10);
  p.g_qa = F(16); p.g_kva = F(17); p.w_uq = F(18); p.w_ukv = F(19); p.w_out[1] = F(20);
  p.conv = F(26); p.b_gate = F(27); p.g_head = F(28); p.w_out[2] = F(29);
  p.sink[3] = F(35); p.w_out[3] = F(36);
  p.out = (float*)d_out; p.ws = (char*)d_ws;
  char* ws = (char*)d_ws;
  bf16_t* HB = (bf16_t*)(ws + OFF_HB);
#if MEGA
  {
    static int grid_blocks = 0;
    if (!grid_blocks) {
      int dev = 0, cus = 0, per_cu = 0;
      (void)hipGetDevice(&dev); (void)hipDeviceGetAttribute(&cus, hipDeviceAttributeMultiprocessorCount, dev);
      (void)hipOccupancyMaxActiveBlocksPerMultiprocessor(&per_cu, k_mega, 512, 0);
      if (per_cu < 1) per_cu = 1;
      grid_blocks = cus * per_cu;
    }
    (void)hipMemsetAsync((char*)d_ws + OFF_BAR, 0, (size_t)XCD_BAR_WORDS * 4, stream);
    void* args[] = {&p};
    hipError_t e = hipLaunchCooperativeKernel((void*)k_mega, dim3(grid_blocks), dim3(512), args, 0, stream);
    if (e != hipSuccess) fprintf(stderr, "cooperative launch failed: %s (grid %d)\n", hipGetErrorString(e), grid_blocks);
    return;
  }
#endif
  const int G = 2048;
  k_prologue<<<1024, 256, 0, stream>>>(p);
  for (int l = 0; l < 4; ++l) {
    const int kind = l == 1 ? 1 : (l == 2 ? 2 : 0);
    bf16_t* Yprev = l == 0 ? nullptr : (bf16_t*)(ws + ((l - 1) == 1 ? ML_Y : (l - 1) == 2 ? LS_Y : GQ_Y));
    k_rowwise<<<G, 256, 0, stream>>>(p, l, Yprev);
    bf16_t* Wi = (bf16_t*)(ws + (l == 0 ? OFF_WIN0 : l == 1 ? OFF_WIN1 : l == 2 ? OFF_WIN2 : OFF_WIN3));
    bf16_t* Wo = (bf16_t*)(ws + OFF_WOUT + (size_t)l * al((size_t)1024 * 1024 * 2));
    bf16_t* Y = (bf16_t*)(ws + (kind == 1 ? ML_Y : kind == 2 ? LS_Y : GQ_Y));
    const int Mout = l == 3 ? NLAT : NT; bf16_t* HBo = HB;
    if (kind == 0) {
      GEMM_L(M_IN_GQA, false)(p, HB, 1024, Wi, 1024, 2560, NT, nullptr);
      ATTN0_L(l);
    } else if (kind == 1) {
      GEMM_L(M_IN_MLA, false)(p, HB, 1024, Wi, 1024, 1472, NT, nullptr);
      GEMM_L(M_UQ, true)(p, (bf16_t*)(ws + ML_QA), 256, (bf16_t*)(ws + OFF_WUQ), 256, 1536, NT, nullptr);
      GEMM_L(M_UKV, true)(p, (bf16_t*)(ws + ML_KVA), 128, (bf16_t*)(ws + OFF_WUKV), 128, 2048, NT, nullptr);
      ATTN1_L();
    } else {
      GEMM_L(M_IN_LSTM, false)(p, HB, 1024, Wi, 1024, 4112, NT, nullptr);
      k_conv<<<G, 256, 0, stream>>>(p);
      k_prep<<<(NITEM + 3) / 4, 256, 0, stream>>>(p);
#if FAST_LSTM
      k_lstm_scan<<<256, 512, 0, stream>>>(p);
      k_lstm_out<<<256, 512, 0, stream>>>(p);
      HBo = (bf16_t*)(ws + LS_OB);
#else
      k_lstm_scan_naive<<<32 * 32768 / 256, 256, 0, stream>>>(p);
      const int shm = (2 * 128 * 129 + 4 * 256) * 4;
      static int attr_done = 0;
      if (!attr_done) { hipFuncSetAttribute((const void*)k_lstm_out_naive, hipFuncAttributeMaxDynamicSharedMemorySize, shm); attr_done = 1; }
      k_lstm_out_naive<<<NB * 4 * NCH, 256, shm, stream>>>(p);
      k_lstm_finish_naive<<<G, 256, 0, stream>>>(p);
#endif
    }
    GEMM_L(M_OUT, false)(p, HBo, 1024, Wo, 1024, 1024, Mout, Y);
  }
  k_rowwise<<<G, 256, 0, stream>>>(p, 4, (bf16_t*)(ws + GQ_Y));
}
```
